# Optimizing an MI355X kernel written in HIP

```python
import math
import jax, jax.numpy as jnp
from jax import lax
import numpy as np

D_MODEL = 1024
BATCH = 16
SEQ = 256
DEPTH = 2
DEC_BATCH = 2
DEC_SEQ = 2048
PAST_LEN = 256

GRID_W = 64
CHUNK = 64
EPS = 1e-6
FFN_DIM = 2816
N_MOD = 9
GLA_HEADS = 4
GLA_DK = 32
GLA_DV = 64
GLA_RANK = 16
GLA_GATE_NORM = 16.0
GDN_HEADS = 4
GDN_DK = 128
GDN_DV = 128
GDN_CONV = 5
S5_GROUPS = 16
S5_CH = 16
S5_P = 64
GLA_W = GLA_HEADS * GLA_DV
GDN_W = GDN_HEADS * GDN_DV
S5_W = S5_GROUPS * S5_CH
MIX_W = GLA_W + GDN_W + S5_W
IN_SIZES = (GLA_HEADS * GLA_DK, GLA_HEADS * GLA_DK, GLA_W, GLA_RANK, GLA_RANK, GLA_W,
            GDN_HEADS * GDN_DK, GDN_HEADS * GDN_DK, GDN_W, GDN_HEADS, GDN_HEADS, GDN_HEADS, GDN_HEADS, GDN_W,
            S5_W)
IN_OFFSETS = tuple(sum(IN_SIZES[:i + 1]) for i in range(len(IN_SIZES) - 1))
IN_W = sum(IN_SIZES)

kernel_name = 'hymba_gla_gdn_s5_diffusion_step'


def _f32(a):
    return a.astype(jnp.float32)


def _rmsnorm(x, w):
    x32 = _f32(x)
    y = x32 * lax.rsqrt(jnp.mean(x32 * x32, axis=-1, keepdims=True) + EPS)
    return y * _f32(w)


def _l2norm(x):
    return x * lax.rsqrt(jnp.sum(x * x, axis=-1, keepdims=True) + EPS)


def _flip(t):
    return jnp.flip(t, axis=1)


def _chunk(t):
    b, n, h, d = t.shape
    return t.reshape(b, n // CHUNK, CHUNK, h, d).transpose(1, 0, 3, 2, 4)


def _unchunk(t):
    n, b, h, c, d = t.shape
    return t.transpose(1, 0, 3, 2, 4).reshape(b, n * c, h, d)


def _swiglu(h, w_gate, w_up, w_down):
    return (jax.nn.silu(h @ _f32(w_gate)) * (h @ _f32(w_up))) @ _f32(w_down)


def _short_conv(x, w, rows):
    b, n, ch = x.shape
    xr = x.reshape(b * rows, n // rows, ch)
    y = lax.conv_general_dilated(xr, _f32(w)[:, None, :], window_strides=(1,),
                                 padding=[(GDN_CONV // 2, GDN_CONV // 2)],
                                 dimension_numbers=('NWC', 'WIO', 'NWC'), feature_group_count=ch)
    return y.reshape(b, n, ch)


def _gla_chunked(q, k, v, log_g, s0):
    qc, kc, vc, gc = (_chunk(t) for t in (q, k, v, log_g))
    bcum = jnp.cumsum(gc, axis=-2)
    incl = jnp.tril(jnp.ones((CHUNK, CHUNK), bool))
    rel = jnp.where(incl[:, :, None], bcum[..., :, None, :] - bcum[..., None, :, :], -jnp.inf)
    att = jnp.einsum('nbhtd,nbhsd,nbhtsd->nbhts', qc, kc, jnp.exp(rel))
    o_intra = jnp.einsum('nbhts,nbhse->nbhte', att, vc)
    q_dec = qc * jnp.exp(bcum)
    k_dec = kc * jnp.exp(bcum[..., -1:, :] - bcum)
    dec_last = jnp.exp(bcum[..., -1, :])

    def step(s, inp):
        qd, kd, vv, dl = inp
        o = jnp.einsum('bhtd,bhde->bhte', qd, s)
        s = dl[..., None] * s + jnp.einsum('bhtd,bhte->bhde', kd, vv)
        return s, o

    s_fin, o_inter = lax.scan(step, s0, (q_dec, k_dec, vc, dec_last))
    return _unchunk(o_inter + o_intra), s_fin


def _gdn_chunked(q, k, v, log_a, beta, s0):
    qc, kc, vc = (_chunk(t) for t in (q, k, v))
    g = jnp.cumsum(_chunk(log_a[..., None])[..., 0], axis=-1)
    bt = _chunk(beta[..., None])[..., 0]
    incl = jnp.tril(jnp.ones((CHUNK, CHUNK), bool))
    strict = jnp.tril(jnp.ones((CHUNK, CHUNK), bool), -1)
    decay = jnp.exp(jnp.where(incl, g[..., :, None] - g[..., None, :], -jnp.inf))
    lmat = jnp.where(strict, decay, 0.0) * jnp.einsum('nbhtd,nbhsd->nbhts', kc, kc) * bt[..., :, None]
    eg = jnp.exp(g)
    rhs = jnp.concatenate([(bt * eg)[..., None] * kc, bt[..., None] * vc], axis=-1)
    sol = lax.linalg.triangular_solve(jnp.eye(CHUNK, dtype=lmat.dtype) + lmat, rhs,
                                      left_side=True, lower=True)
    w, u0 = jnp.split(sol, [kc.shape[-1]], axis=-1)
    qk = jnp.einsum('nbhtd,nbhsd->nbhts', qc, kc) * decay
    k_dec = kc * jnp.exp(g[..., -1:] - g)[..., None]
    eg_last = eg[..., -1]

    def step(s, inp):
        w_c, u0_c, q_c, kd_c, qk_c, eg_c, egl_c = inp
        u = u0_c - jnp.einsum('bhtd,bhde->bhte', w_c, s)
        o = eg_c[..., None] * jnp.einsum('bhtd,bhde->bhte', q_c, s) + jnp.einsum('bhts,bhse->bhte', qk_c, u)
        s = egl_c[..., None, None] * s + jnp.einsum('bhtd,bhte->bhde', kd_c, u)
        return s, o

    s_fin, o = lax.scan(step, s0, (w, u0, qc, k_dec, qk, eg, eg_last))
    return _unchunk(o), s_fin


def _s5_scan(u, lam_re, lam_im, log_step, b_re, b_im, c_re, c_im, h0_re, h0_im):
    lam = lax.complex(_f32(lam_re), _f32(lam_im))
    lam_dt = lam * jnp.exp(_f32(log_step))[:, None]
    lam_bar = jnp.exp(lam_dt)
    b_bar = ((lam_bar - 1.0) / lam)[..., None] * lax.complex(_f32(b_re), _f32(b_im))
    c_mat = lax.complex(_f32(c_re), _f32(c_im))
    bu = jnp.einsum('gpc,bngc->bngp', b_bar, u.astype(jnp.complex64))
    a = jnp.broadcast_to(lam_bar, bu.shape)

    def combine(left, right):
        a_l, b_l = left
        a_r, b_r = right
        return a_r * a_l, a_r * b_l + b_r

    _, h = lax.associative_scan(combine, (a, bu), axis=1)
    n = u.shape[1]
    pos = jnp.arange(1, n + 1, dtype=jnp.float32)[:, None, None]
    h = h + jnp.exp(lam_dt[None] * pos)[None] * lax.complex(_f32(h0_re), _f32(h0_im))[:, None]
    y = jnp.real(jnp.einsum('gcp,bngp->bngc', c_mat, h))
    return y, h[:, -1]


def _token_mix(h, rows, states, p, l):
    st_gla, st_gdn, st_s5_re, st_s5_im = (_f32(s) for s in states)
    b, n, _ = h.shape
    (gq, gk, gv, glr_f, glr_b, gog, dq, dk, dv, da_f, da_b, db_f, db_b, dog, su) = jnp.split(
        h @ _f32(p['w_in'][l]), IN_OFFSETS, axis=-1)

    q = gq.reshape(b, n, GLA_HEADS, GLA_DK) * GLA_DK ** -0.5
    k = gk.reshape(b, n, GLA_HEADS, GLA_DK)
    v = gv.reshape(b, n, GLA_HEADS, GLA_DV)
    o_gla = jnp.zeros((b, n, GLA_HEADS, GLA_DV), jnp.float32)
    fin_gla = []
    for d, lowrank in enumerate((glr_f, glr_b)):
        lg = jax.nn.log_sigmoid(lowrank @ _f32(p['gla_gk_up'][l, d]) + _f32(p['gla_gk_bias'][l, d])) / GLA_GATE_NORM
        lg = lg.reshape(b, n, GLA_HEADS, GLA_DK)
        args = (q, k, v, lg) if d == 0 else tuple(_flip(t) for t in (q, k, v, lg))
        o, s = _gla_chunked(*args, st_gla[:, d])
        o_gla = o_gla + (o if d == 0 else _flip(o))
        fin_gla.append(s)
    o_gla = _rmsnorm(o_gla, p['gla_norm_w'][l]) * jax.nn.silu(gog.reshape(b, n, GLA_HEADS, GLA_DV))
    o_gla = o_gla.reshape(b, n, GLA_W)

    qkv = jax.nn.silu(_short_conv(jnp.concatenate([dq, dk, dv], axis=-1), p['gdn_conv_w'][l], rows))
    q, k, v = jnp.split(qkv, [GDN_HEADS * GDN_DK, 2 * GDN_HEADS * GDN_DK], axis=-1)
    q = _l2norm(q.reshape(b, n, GDN_HEADS, GDN_DK)) * GDN_DK ** -0.5
    k = _l2norm(k.reshape(b, n, GDN_HEADS, GDN_DK))
    v = v.reshape(b, n, GDN_HEADS, GDN_DV)
    o_gdn = jnp.zeros((b, n, GDN_HEADS, GDN_DV), jnp.float32)
    fin_gdn = []
    for d, (a_raw, b_raw) in enumerate(((da_f, db_f), (da_b, db_b))):
        log_a = -jnp.exp(_f32(p['gdn_a_log'][l, d])) * jax.nn.softplus(a_raw + _f32(p['gdn_dt_bias'][l, d]))
        beta = jax.nn.sigmoid(b_raw)
        args = (q, k, v, log_a, beta) if d == 0 else tuple(_flip(t) for t in (q, k, v, log_a, beta))
        o, s = _gdn_chunked(*args, st_gdn[:, d])
        o_gdn = o_gdn + (o if d == 0 else _flip(o))
        fin_gdn.append(s)
    o_gdn = _rmsnorm(o_gdn, p['gdn_norm_w'][l]) * jax.nn.silu(dog.reshape(b, n, GDN_HEADS, GDN_DV))
    o_gdn = o_gdn.reshape(b, n, GDN_W)

    u = su.reshape(b, n, S5_GROUPS, S5_CH)
    y = u * _f32(p['s5_d'][l]).reshape(S5_GROUPS, S5_CH)
    fin_s5 = []
    for d in range(2):
        ud = u if d == 0 else _flip(u)
        yd, hf = _s5_scan(ud, p['s5_lam_re'][l, d], p['s5_lam_im'][l, d], p['s5_log_step'][l, d],
                          p['s5_b_re'][l, d], p['s5_b_im'][l, d], p['s5_c_re'][l, d], p['s5_c_im'][l, d],
                          st_s5_re[:, d], st_s5_im[:, d])
        y = y + (yd if d == 0 else _flip(yd))
        fin_s5.append(hf)
    g = jax.nn.gelu(y.reshape(b, n, S5_W))
    o_s5 = g * jax.nn.sigmoid(g @ _f32(p['s5_w_glu'][l]) + _f32(p['s5_b_glu'][l]))

    out = jnp.concatenate([o_gla, o_gdn, o_s5], axis=-1) @ _f32(p['w_out'][l])
    h_s5 = jnp.stack(fin_s5, axis=1)
    new = (jnp.stack(fin_gla, axis=1), jnp.stack(fin_gdn, axis=1), jnp.real(h_s5), jnp.imag(h_s5))
    return out, new


def _trunk(x, cond, rows, states, p):
    act = x.dtype
    sc = jax.nn.silu(_f32(cond))
    finals = []
    for l in range(DEPTH):
        mod = (sc @ _f32(p['w_ada'][l]) + _f32(p['b_ada'][l]))[:, None, :]
        sh1, sc1, g1, sh2, sc2, g2, sh3, sc3, g3 = jnp.split(mod, N_MOD, axis=-1)
        h = _rmsnorm(x, p['norm_w'][l, 0]) * (1.0 + sc1) + sh1
        x = x + (0.5 * g1 * _swiglu(h, p['ffn_w_gate'][l, 0], p['ffn_w_up'][l, 0], p['ffn_w_down'][l, 0])).astype(act)
        h = _rmsnorm(x, p['norm_w'][l, 1]) * (1.0 + sc2) + sh2
        y, st = _token_mix(h, rows, tuple(s[:, l] for s in states), p, l)
        x = x + (g2 * y).astype(act)
        h = _rmsnorm(x, p['norm_w'][l, 2]) * (1.0 + sc3) + sh3
        x = x + (0.5 * g3 * _swiglu(h, p['ffn_w_gate'][l, 1], p['ffn_w_up'][l, 1], p['ffn_w_down'][l, 1])).astype(act)
        finals.append(st)
    return _rmsnorm(x, p['final_norm_w']).astype(act), finals


def setup_inputs(seed: int = 0) -> dict:
    key = jax.random.key(seed)
    keys = jax.random.split(key, 40)

    def nrm(i, shape, s):
        return jax.random.normal(keys[i], shape, jnp.float32) * s

    def unif(i, shape, lo, hi):
        return jax.random.uniform(keys[i], shape, jnp.float32, minval=lo, maxval=hi)

    L = DEPTH
    dt = jnp.exp(unif(14, (L, 2, GDN_HEADS), math.log(1e-3), math.log(1e-1)))
    n_idx = jnp.arange(S5_P, dtype=jnp.float32)
    return {
        'x_prompt': nrm(0, (BATCH, SEQ, D_MODEL), 1.0),
        'x_sample': nrm(1, (DEC_BATCH, DEC_SEQ, D_MODEL), 1.0),
        'c': nrm(2, (DEC_BATCH, D_MODEL), 1.0),
        'state_gla': nrm(3, (DEC_BATCH, L, 2, GLA_HEADS, GLA_DK, GLA_DV), 0.1),
        'state_gdn': nrm(4, (DEC_BATCH, L, 2, GDN_HEADS, GDN_DK, GDN_DV), 0.1),
        'state_s5_re': nrm(5, (DEC_BATCH, L, 2, S5_GROUPS, S5_P), 0.5),
        'state_s5_im': nrm(6, (DEC_BATCH, L, 2, S5_GROUPS, S5_P), 0.5),
        'c_ctx': nrm(7, (D_MODEL,), 1.0),
        'w_ada': nrm(8, (L, D_MODEL, N_MOD * D_MODEL), D_MODEL ** -0.5),
        'b_ada': nrm(9, (L, N_MOD * D_MODEL), 0.02),
        'norm_w': 1.0 + nrm(10, (L, 3, D_MODEL), 0.05),
        'ffn_w_gate': nrm(11, (L, 2, D_MODEL, FFN_DIM), D_MODEL ** -0.5),
        'ffn_w_up': nrm(12, (L, 2, D_MODEL, FFN_DIM), D_MODEL ** -0.5),
        'ffn_w_down': nrm(13, (L, 2, FFN_DIM, D_MODEL), FFN_DIM ** -0.5),
        'w_in': nrm(15, (L, D_MODEL, IN_W), D_MODEL ** -0.5),
        'gla_gk_up': nrm(16, (L, 2, GLA_RANK, GLA_HEADS * GLA_DK), GLA_RANK ** -0.5),
        'gla_gk_bias': nrm(17, (L, 2, GLA_HEADS * GLA_DK), 0.1),
        'gla_norm_w': 1.0 + nrm(18, (L, GLA_DV), 0.05),
        'gdn_conv_w': nrm(19, (L, GDN_CONV, 2 * GDN_HEADS * GDN_DK + GDN_W), GDN_CONV ** -0.5),
        'gdn_a_log': jnp.log(unif(20, (L, 2, GDN_HEADS), 1.0, 16.0)),
        'gdn_dt_bias': dt + jnp.log(-jnp.expm1(-dt)),
        'gdn_norm_w': 1.0 + nrm(21, (L, GDN_DV), 0.05),
        's5_lam_re': -0.5 + nrm(22, (L, 2, S5_GROUPS, S5_P), 0.01),
        's5_lam_im': math.pi * n_idx + nrm(23, (L, 2, S5_GROUPS, S5_P), 0.01),
        's5_log_step': unif(24, (L, 2, S5_GROUPS), math.log(1e-3), math.log(1e-1)),
        's5_b_re': nrm(25, (L, 2, S5_GROUPS, S5_P, S5_CH), (2 * S5_CH) ** -0.5),
        's5_b_im': nrm(26, (L, 2, S5_GROUPS, S5_P, S5_CH), (2 * S5_CH) ** -0.5),
        's5_c_re': nrm(27, (L, 2, S5_GROUPS, S5_CH, S5_P), (2 * S5_P) ** -0.5),
        's5_c_im': nrm(28, (L, 2, S5_GROUPS, S5_CH, S5_P), (2 * S5_P) ** -0.5),
        's5_d': nrm(29, (L, S5_W), 1.0),
        's5_w_glu': nrm(30, (L, S5_W, S5_W), S5_W ** -0.5),
        's5_b_glu': nrm(31, (L, S5_W), 0.02),
        'w_out': nrm(32, (L, MIX_W, D_MODEL), MIX_W ** -0.5),
        'final_norm_w': 1.0 + nrm(33, (D_MODEL,), 0.05),
    }


def reference(x_prompt, x_sample, c, state_gla, state_gdn, state_s5_re, state_s5_im, c_ctx,
              w_ada, b_ada, norm_w, ffn_w_gate, ffn_w_up, ffn_w_down, w_in,
              gla_gk_up, gla_gk_bias, gla_norm_w, gdn_conv_w, gdn_a_log, gdn_dt_bias, gdn_norm_w,
              s5_lam_re, s5_lam_im, s5_log_step, s5_b_re, s5_b_im, s5_c_re, s5_c_im, s5_d,
              s5_w_glu, s5_b_glu, w_out, final_norm_w):
    p = dict(w_ada=w_ada, b_ada=b_ada, norm_w=norm_w, ffn_w_gate=ffn_w_gate, ffn_w_up=ffn_w_up,
             ffn_w_down=ffn_w_down, w_in=w_in, gla_gk_up=gla_gk_up, gla_gk_bias=gla_gk_bias,
             gla_norm_w=gla_norm_w, gdn_conv_w=gdn_conv_w, gdn_a_log=gdn_a_log, gdn_dt_bias=gdn_dt_bias,
             gdn_norm_w=gdn_norm_w, s5_lam_re=s5_lam_re, s5_lam_im=s5_lam_im, s5_log_step=s5_log_step,
             s5_b_re=s5_b_re, s5_b_im=s5_b_im, s5_c_re=s5_c_re, s5_c_im=s5_c_im, s5_d=s5_d,
             s5_w_glu=s5_w_glu, s5_b_glu=s5_b_glu, w_out=w_out, final_norm_w=final_norm_w)

    b_ctx = x_prompt.shape[0]
    zero_states = (jnp.zeros((b_ctx, DEPTH, 2, GLA_HEADS, GLA_DK, GLA_DV), jnp.float32),
                   jnp.zeros((b_ctx, DEPTH, 2, GDN_HEADS, GDN_DK, GDN_DV), jnp.float32),
                   jnp.zeros((b_ctx, DEPTH, 2, S5_GROUPS, S5_P), jnp.float32),
                   jnp.zeros((b_ctx, DEPTH, 2, S5_GROUPS, S5_P), jnp.float32))
    y_prompt, ctx_finals = _trunk(x_prompt, c_ctx[None, :], 1, zero_states, p)
    new_state_gla = jnp.stack([f[0] for f in ctx_finals], axis=1).astype(state_gla.dtype)
    new_state_gdn = jnp.stack([f[1] for f in ctx_finals], axis=1).astype(state_gdn.dtype)
    new_state_s5_re = jnp.stack([f[2] for f in ctx_finals], axis=1).astype(state_s5_re.dtype)
    new_state_s5_im = jnp.stack([f[3] for f in ctx_finals], axis=1).astype(state_s5_im.dtype)

    rows = x_sample.shape[1] // GRID_W
    y_sample, _ = _trunk(x_sample, c, rows, (state_gla, state_gdn, state_s5_re, state_s5_im), p)
    return (y_prompt, y_sample, new_state_gla, new_state_gdn, new_state_s5_re, new_state_s5_im)
```

```cpp
#include <hip/hip_runtime.h>
#include <cstdio>
#include <cstdint>
#define LAS __attribute__((address_space(3)))
#define GAS __attribute__((address_space(1)))
namespace pg8 {
#define PG8_LAS __attribute__((address_space(3)))
typedef unsigned short bf16_t;
typedef short bf16x8 __attribute__((ext_vector_type(8)));
typedef float f32x4 __attribute__((ext_vector_type(4)));
typedef unsigned u32x4 __attribute__((ext_vector_type(4)));
constexpr int BM = 256, BK = 64, HALF = 128, HTB = HALF * BK * 2  , STAGE_BYTES = 8 * HTB, NXCD = 8, WGM = 8;

__host__ __device__ __forceinline__ int lds_byte(int r, int c) { const int st = (r >> 4) * 2 + (c >> 5), rr = r & 15, cc = c & 31, ob = rr * 64 + cc * 2; return st * 1024 + (ob ^ (((ob >> 9) & 1) << 5)); }
__host__ __device__ __forceinline__ void stage_rc(int b, int& R, int& C) { const int st = b / 1024, sb = b % 1024, swz = sb ^ (((sb >> 9) & 1) << 5); R = (st >> 1) * 16 + swz / 64; C = (st & 1) * 32 + (swz % 64) / 2; }
__host__ __device__ __forceinline__ int perm32(int rho) { const int n = rho >> 4, i = rho & 15; return 8 * (i >> 2) + 4 * n + (i & 3); }

struct Unit { int pm, pn, kh, idx; };
struct Gemm { const bf16_t* A; const bf16_t* Bt; int M, N, K, ld; };

struct StaticOrder {
    int nM, nN, nNr, nwg, G, c;
    __host__ __device__ void init(int M, int N, int G_, int c_, int ksplit = 1, int bn = BM) { nM = M / BM; nNr = N / bn; nN = nNr * ksplit; nwg = nM * nN; G = G_; c = c_; }
    __host__ __device__ bool next(int i, Unit& u) const {
        const long L = (long)i * G + c; if (L >= nwg) return false;
        int wgid = (int)L; { const int q = nwg / NXCD, r = nwg % NXCD, xcd = wgid % NXCD, off = wgid / NXCD; wgid = (xcd < r ? xcd * (q + 1) : r * (q + 1) + (xcd - r) * q) + off; }
        const int nig = WGM * nN, gid = wgid / nig, fm = gid * WGM, gsz = (nM - fm) < WGM ? (nM - fm) : WGM;
        u.pm = fm + ((wgid % nig) % gsz); const int pnr = (wgid % nig) / gsz; u.pn = pnr % nNr; u.kh = pnr / nNr; u.idx = i; return true;
    }
    __device__ __forceinline__ void a_ready(const Unit&) const {}
    __device__ __forceinline__ void done(const Unit&) const {}
};

__device__ __forceinline__ unsigned cvt_pk_bf16(float lo, float hi) { unsigned r; asm volatile("v_cvt_pk_bf16_f32 %0, %1, %2" : "=v"(r) : "v"(lo), "v"(hi)); return r; }
typedef float f32x2 __attribute__((ext_vector_type(2)));
template <class Epi, class Sched, bool ALIGN_EPI = false, bool SP2 = false, bool NB1 = false>
__device__ __forceinline__ void gemm_phase(PG8_LAS unsigned char* lds, const Gemm g, const Sched& S, const Epi& E, const int tid) {
    const int wid = __builtin_amdgcn_readfirstlane(tid >> 6), lane = tid & 63, wr = wid >> 2, wc = wid & 3, fr = lane & 15, fq = lane >> 4;
    const int K = g.K, ld = g.ld, nt = K / BK;
    unsigned voffA[2], voffB[2];
#pragma unroll
    for (int i = 0; i < 2; ++i) { int R, C; stage_rc(tid * 16 + i * 8192, R, C); const int Rb = Epi::PERM ? ((R & ~31) + perm32(R & 31)) : R;
        voffA[i] = (unsigned)(R * ld + C) * 2u; voffB[i] = (unsigned)(Rb * ld + C) * 2u; }
    const size_t kstep = (size_t)(BK * 2);
    const size_t hstep = (size_t)HALF * ld * 2;
    const size_t tstep = 2 * hstep;
    const unsigned ldsw = (unsigned)wid * 1024u;
    const int aoff = lds_byte(wr * 64 + fr, fq * 8), boff = lds_byte(wc * 32 + fr, fq * 8);
#define PG8_SA(b, h) (((b) * 2 + (h)) * HTB)
#define PG8_SB(b, h) ((4 + (b) * 2 + (h)) * HTB)
#define PG8_STAGE(bufoff, gbase, voff) do { _Pragma("unroll") for (int _i = 0; _i < 2; ++_i) \
        __builtin_amdgcn_global_load_lds((const unsigned*)((const char*)(gbase) + (voff)[_i]), (PG8_LAS unsigned*)(lds + (bufoff) + ldsw + _i * 8192), 16, 0, 0); } while (0)
#define PG8_LDA(dst, b, h) do { _Pragma("unroll") for (int m = 0; m < 4; ++m) _Pragma("unroll") for (int k = 0; k < 2; ++k) dst[m][k] = *(const PG8_LAS bf16x8*)(lds + PG8_SA(b, h) + aoff + m * 2048 + k * 1024); } while (0)
#define PG8_LDB(dst, b, h) do { _Pragma("unroll") for (int n = 0; n < 2; ++n) _Pragma("unroll") for (int k = 0; k < 2; ++k) dst[n][k] = *(const PG8_LAS bf16x8*)(lds + PG8_SB(b, h) + boff + n * 2048 + k * 1024); } while (0)
#define PG8_MMA(ai, bj, At, Bt) do { __builtin_amdgcn_s_setprio(1); _Pragma("unroll") for (int m = 0; m < 4; ++m) _Pragma("unroll") for (int n = 0; n < 2; ++n) _Pragma("unroll") for (int k = 0; k < 2; ++k) \
        acc[ai][bj][m][n] = __builtin_amdgcn_mfma_f32_16x16x32_bf16(Bt[n][k], At[m][k], acc[ai][bj][m][n], 0, 0, 0); __builtin_amdgcn_s_setprio(0); } while (0)
#define PG8_WAIT_V(n) asm volatile("s_waitcnt vmcnt(" #n ")" ::: "memory")
#define PG8_WAIT_L(n) asm volatile("s_waitcnt lgkmcnt(" #n ")" ::: "memory")
#define PG8_BAR __builtin_amdgcn_s_barrier()
#define PG8_SCHED __builtin_amdgcn_sched_barrier(0)
    Unit cur, nxt; int ui = 0;
    if (!S.next(0, cur)) return;
    f32x4 acc[2][2][4][2];
#pragma unroll
    for (int a = 0; a < 2; ++a)
#pragma unroll
        for (int b = 0; b < 2; ++b)
#pragma unroll
            for (int m = 0; m < 4; ++m)
#pragma unroll
                for (int n = 0; n < 2; ++n) acc[a][b][m][n] = (f32x4){0.f, 0.f, 0.f, 0.f};
    bf16x8 At[4][2], B0[2][2], B1[2][2];
    const char* cA = (const char*)g.A + (size_t)cur.pm * tstep + (size_t)cur.kh * K * 2; const char* cB = (const char*)g.Bt + (size_t)cur.pn * (NB1 ? hstep : tstep) + (size_t)cur.kh * K * 2;
    S.a_ready(cur);
    if constexpr (SP2) {
        PG8_STAGE(PG8_SB(0, 0), cB, voffB); if constexpr (!NB1) PG8_STAGE(PG8_SB(0, 1), cB + hstep, voffB); PG8_STAGE(PG8_SA(0, 0), cA, voffA); PG8_STAGE(PG8_SA(0, 1), cA + hstep, voffA);
        if (wr == 1) PG8_BAR;
        PG8_WAIT_V(2); PG8_BAR;
        PG8_STAGE(PG8_SB(1, 0), cB + kstep, voffB); PG8_STAGE(PG8_SA(1, 0), cA + kstep, voffA); if constexpr (!NB1) PG8_STAGE(PG8_SB(1, 1), cB + hstep + kstep, voffB);
        if constexpr (NB1) PG8_WAIT_V(4); else PG8_WAIT_V(6);
        PG8_BAR;
    } else {
        PG8_STAGE(PG8_SB(0, 0), cB, voffB); PG8_STAGE(PG8_SA(0, 0), cA, voffA); PG8_STAGE(PG8_SB(0, 1), cB + hstep, voffB); PG8_STAGE(PG8_SA(0, 1), cA + hstep, voffA);
        if (wr == 1) PG8_BAR;
        PG8_WAIT_V(4); PG8_BAR;
        PG8_STAGE(PG8_SB(1, 0), cB + kstep, voffB); PG8_STAGE(PG8_SA(1, 0), cA + kstep, voffA); PG8_STAGE(PG8_SB(1, 1), cB + hstep + kstep, voffB);
        PG8_WAIT_V(6); PG8_BAR;
    }
    for (;;) {
        const bool has_next = S.next(ui + 1, nxt);
        const char* nA = has_next ? (const char*)g.A + (size_t)nxt.pm * tstep + (size_t)nxt.kh * K * 2 : cA; const char* nB = has_next ? (const char*)g.Bt + (size_t)nxt.pn * (NB1 ? hstep : tstep) + (size_t)nxt.kh * K * 2 : cB;
        for (int t = 0; t < nt; t += 2) {
            const bool last = (t == nt - 2);
            const char* a1 = cA + (size_t)(t + 1) * kstep;
            const char* a2 = last ? nA : cA + (size_t)(t + 2) * kstep; const char* b2 = last ? nB : cB + (size_t)(t + 2) * kstep;
            const char* a3 = a2 + kstep; const char* b3 = b2 + kstep;
            if (last && has_next) S.a_ready(nxt);
            if constexpr (SP2) {
            if constexpr (!NB1) {
            PG8_LDB(B0, 0, 0); PG8_LDB(B1, 0, 1); PG8_SCHED; PG8_LDA(At, 0, 0); PG8_STAGE(PG8_SA(1, 1), a1 + hstep, voffA);
            PG8_WAIT_V(8); PG8_WAIT_L(0); PG8_BAR; PG8_MMA(0, 0, At, B0); PG8_MMA(0, 1, At, B1); PG8_BAR; PG8_SCHED;
            PG8_LDA(At, 0, 1); PG8_STAGE(PG8_SB(0, 0), b2, voffB); PG8_STAGE(PG8_SB(0, 1), b2 + hstep, voffB); PG8_STAGE(PG8_SA(0, 0), a2, voffA);
            PG8_WAIT_V(8); PG8_WAIT_L(0); PG8_BAR; PG8_MMA(1, 0, At, B0); PG8_MMA(1, 1, At, B1); PG8_BAR; PG8_SCHED;
            PG8_LDB(B0, 1, 0); PG8_LDB(B1, 1, 1); PG8_SCHED; PG8_LDA(At, 1, 0); PG8_STAGE(PG8_SA(0, 1), a2 + hstep, voffA);
            PG8_WAIT_V(8); PG8_WAIT_L(0); PG8_BAR; PG8_MMA(0, 0, At, B0); PG8_MMA(0, 1, At, B1); PG8_BAR; PG8_SCHED;
            PG8_LDA(At, 1, 1); PG8_STAGE(PG8_SB(1, 0), b3, voffB); PG8_STAGE(PG8_SB(1, 1), b3 + hstep, voffB); PG8_STAGE(PG8_SA(1, 0), a3, voffA);
            PG8_WAIT_V(8); PG8_WAIT_L(0); PG8_BAR; PG8_MMA(1, 0, At, B0); PG8_MMA(1, 1, At, B1); PG8_BAR; PG8_SCHED;
            } else {
            PG8_LDB(B0, 0, 0); PG8_SCHED; PG8_LDA(At, 0, 0); PG8_STAGE(PG8_SA(1, 1), a1 + hstep, voffA);
            PG8_WAIT_V(6); PG8_WAIT_L(0); PG8_BAR; PG8_MMA(0, 0, At, B0); PG8_BAR; PG8_SCHED;
            PG8_LDA(At, 0, 1); PG8_STAGE(PG8_SB(0, 0), b2, voffB); PG8_STAGE(PG8_SA(0, 0), a2, voffA);
            PG8_WAIT_V(6); PG8_WAIT_L(0); PG8_BAR; PG8_MMA(1, 0, At, B0); PG8_BAR; PG8_SCHED;
            PG8_LDB(B0, 1, 0); PG8_SCHED; PG8_LDA(At, 1, 0); PG8_STAGE(PG8_SA(0, 1), a2 + hstep, voffA);
            PG8_WAIT_V(6); PG8_WAIT_L(0); PG8_BAR; PG8_MMA(0, 0, At, B0); PG8_BAR; PG8_SCHED;
            PG8_LDA(At, 1, 1); PG8_STAGE(PG8_SB(1, 0), b3, voffB); PG8_STAGE(PG8_SA(1, 0), a3, voffA);
            PG8_WAIT_V(6); PG8_WAIT_L(0); PG8_BAR; PG8_MMA(1, 0, At, B0); PG8_BAR; PG8_SCHED;
            }
            } else {
            PG8_LDB(B0, 0, 0); PG8_SCHED; PG8_LDA(At, 0, 0); PG8_STAGE(PG8_SA(1, 1), a1 + hstep, voffA);
            PG8_WAIT_L(8); PG8_BAR; PG8_WAIT_L(0); PG8_MMA(0, 0, At, B0); PG8_BAR; PG8_SCHED;
            PG8_LDB(B1, 0, 1); PG8_STAGE(PG8_SB(0, 0), b2, voffB);
            PG8_BAR; PG8_WAIT_L(0); PG8_MMA(0, 1, At, B1); PG8_BAR;
            PG8_LDA(At, 0, 1); PG8_STAGE(PG8_SA(0, 0), a2, voffA);
            PG8_BAR; PG8_WAIT_L(0); PG8_MMA(1, 0, At, B0); PG8_BAR; PG8_SCHED;
            PG8_STAGE(PG8_SB(0, 1), b2 + hstep, voffB);
            PG8_WAIT_V(6); PG8_BAR; PG8_MMA(1, 1, At, B1); PG8_BAR;
            PG8_LDB(B0, 1, 0); PG8_SCHED; PG8_LDA(At, 1, 0); PG8_STAGE(PG8_SA(0, 1), a2 + hstep, voffA);
            PG8_WAIT_L(8); PG8_BAR; PG8_WAIT_L(0); PG8_MMA(0, 0, At, B0); PG8_BAR; PG8_SCHED;
            PG8_LDB(B1, 1, 1); PG8_STAGE(PG8_SB(1, 0), b3, voffB);
            PG8_BAR; PG8_WAIT_L(0); PG8_MMA(0, 1, At, B1); PG8_BAR;
            PG8_LDA(At, 1, 1); PG8_STAGE(PG8_SA(1, 0), a3, voffA);
            PG8_BAR; PG8_WAIT_L(0); PG8_MMA(1, 0, At, B0); PG8_BAR; PG8_SCHED;
            PG8_STAGE(PG8_SB(1, 1), b3 + hstep, voffB);
            PG8_WAIT_V(6); PG8_BAR; PG8_MMA(1, 1, At, B1); PG8_BAR;
            }
        }
        if constexpr (ALIGN_EPI) { if (wr == 0) PG8_BAR; }
        if constexpr (!Epi::AFTER_DRAIN) { E(acc, cur, wr, wc, fr, fq); S.done(cur); }
        if (!has_next) break;
#pragma unroll
        for (int a = 0; a < 2; ++a)
#pragma unroll
            for (int b = 0; b < 2; ++b)
#pragma unroll
                for (int m = 0; m < 4; ++m)
#pragma unroll
                    for (int n = 0; n < 2; ++n) acc[a][b][m][n] = (f32x4){0.f, 0.f, 0.f, 0.f};
        cur = nxt; cA = nA; cB = nB; ++ui;
        if constexpr (ALIGN_EPI) { if (wr == 1) PG8_BAR; }
    }
    PG8_WAIT_V(0);
    if constexpr (!ALIGN_EPI) { if (wr == 0) PG8_BAR; }
    PG8_BAR;
    if constexpr (Epi::AFTER_DRAIN) { E.fused(acc, cur, wr, wc, fr, fq, lds, wid, lane); S.done(cur); }
#undef PG8_SA
#undef PG8_SB
#undef PG8_STAGE
#undef PG8_LDA
#undef PG8_LDB
#undef PG8_MMA
#undef PG8_WAIT_V
#undef PG8_WAIT_L
#undef PG8_BAR
#undef PG8_SCHED
}
}
#define XB_TMO      128
#define XB_XCNT(j)  (256  + 64 * (j))
#define XB_XSUB(j)  (1280 + 64 * (j))
#define XB_XGEN(j)  (2304 + 64 * (j))
#define XB_TOP      3328
#define XB_TOPGEN   3392
#define XCD_BAR_WORDS 3456
#define XB_SPIN_CAP (1u << 18)

__device__ __forceinline__ unsigned xb_ld(unsigned* p)              { return __hip_atomic_load(p, __ATOMIC_RELAXED, __HIP_MEMORY_SCOPE_AGENT); }
__device__ __forceinline__ unsigned xb_add(unsigned* p, unsigned v) { return __hip_atomic_fetch_add(p, v, __ATOMIC_RELAXED, __HIP_MEMORY_SCOPE_AGENT); }
__device__ __forceinline__ unsigned xb_xcc_id() { return (unsigned)__builtin_amdgcn_s_getreg((3 << 11) | 20) & 0xFu; }
#define XB_SPIN(cond, bar) do { unsigned _sp = 0; while (cond) { __builtin_amdgcn_s_sleep(1); \
    if ((++_sp & 255u) == 0u) { if (xb_ld(&(bar)[XB_TMO])) break; if (_sp > XB_SPIN_CAP) { atomicAdd(&(bar)[XB_TMO], 1u); break; } } } } while (0)

struct XcdBarrier {
    unsigned* bar; unsigned x;
    volatile LAS unsigned* st;
};

__device__ __forceinline__ XcdBarrier xcd_barrier_post(unsigned* bar, volatile LAS unsigned* st) {
    XcdBarrier b; b.bar = bar; b.x = xb_xcc_id(); b.st = st;
    if (threadIdx.x == 0) (void)xb_add(&bar[XB_XCNT(b.x)], 1u);
    return b;
}
__device__ __forceinline__ void xcd_barrier_complete(unsigned* bar, unsigned x, unsigned& nloc, unsigned& nx) {
    const unsigned G = gridDim.x * gridDim.y * gridDim.z;
    unsigned sum, cnt, mine, sp = 0u;
    for (;;) {
        sum = 0u; cnt = 0u; mine = 0u;
#pragma unroll
        for (unsigned j = 0; j < 16; ++j) { const unsigned c = xb_ld(&bar[XB_XCNT(j)]); sum += c; cnt += (c > 0u) ? 1u : 0u; mine = (j == x) ? c : mine; }
        if (sum == G) break;
        __builtin_amdgcn_s_sleep(1);
        if ((++sp & 255u) == 0u) { if (xb_ld(&bar[XB_TMO])) break; if (sp > XB_SPIN_CAP) { atomicAdd(&bar[XB_TMO], 1u); break; } }
    }
    nloc = mine > 0u ? mine : 1u; nx = cnt > 0u ? cnt : 1u;
}

__device__ __forceinline__ void xcd_barrier(const XcdBarrier& b) {
    asm volatile("s_waitcnt vmcnt(0)" ::: "memory");
    __syncthreads();
    if (threadIdx.x == 0) {
        unsigned* bar = b.bar;
        __builtin_amdgcn_s_waitcnt(0);
        unsigned nloc = b.st[0], nx = b.st[1];
        if (nloc == 0u) { xcd_barrier_complete(bar, b.x, nloc, nx); b.st[0] = nloc; b.st[1] = nx; }
        const unsigned old = xb_add(&bar[XB_XSUB(b.x)], 1u);
        const unsigned gen = old / nloc;
        if (old + 1u == (gen + 1u) * nloc) {
            __builtin_amdgcn_fence(__ATOMIC_RELEASE, "agent");
            asm volatile("s_waitcnt vmcnt(0)" ::: "memory");
            const unsigned og = xb_add(&bar[XB_TOP], 1u);
            const unsigned tg = og / nx;
            if (og + 1u == (tg + 1u) * nx) xb_add(&bar[XB_TOPGEN], 1u);
            else XB_SPIN(xb_ld(&bar[XB_TOPGEN]) == tg, bar);
            __builtin_amdgcn_fence(__ATOMIC_ACQUIRE, "agent");
            xb_add(&bar[XB_XGEN(b.x)], 1u);
            asm volatile("s_waitcnt vmcnt(0)" ::: "memory");
        } else {
            XB_SPIN(xb_ld(&bar[XB_XGEN(b.x)]) == gen, bar);
            __builtin_amdgcn_fence(__ATOMIC_ACQUIRE, "agent");
            asm volatile("s_waitcnt vmcnt(0)" ::: "memory");
        }
    }
    __syncthreads();
}
typedef unsigned short bf16;
typedef unsigned v4u __attribute__((ext_vector_type(4)));
typedef unsigned v2u __attribute__((ext_vector_type(2)));
typedef float f32x4 __attribute__((ext_vector_type(4)));
typedef float f32x2 __attribute__((ext_vector_type(2)));
constexpr int NWAVES = 8, NTHR = 512;
constexpr int D = 1024, FF = 2816, NGU = 2 * FF, NIN = 3120, NINP = 3328, M = 8192, MCTX = 4096;
constexpr int C_GQ = 0, C_GK = 128, C_GV = 256, C_GLRF = 512, C_GLRB = 528, C_GOG = 544, C_DQ = 800, C_DK = 1312, C_DV = 1824,
              C_DAF = 2336, C_DAB = 2340, C_DBF = 2344, C_DBB = 2348, C_DOG = 2352, C_SU = 2864;
constexpr size_t O_Y = 0, O_SGLA = (size_t)M * D, O_SGDN = O_SGLA + 524288, O_S5RE = O_SGDN + 4194304, O_S5IM = O_S5RE + 65536, O_END = O_S5IM + 65536;
constexpr size_t MiB = 1u << 20;
constexpr size_t WS_CTL = 0, CTL_ZERO_BYTES = 1 * MiB;
constexpr size_t WS_MOD = 1 * MiB;
constexpr size_t WS_WGU = 2 * MiB;
constexpr size_t WS_WD = 26 * MiB;
constexpr size_t WS_WIN = 37 * MiB;
constexpr size_t WS_WOUT = 44 * MiB;
constexpr size_t WS_HN = 46 * MiB;
constexpr size_t WS_PROJ = 62 * MiB;
constexpr size_t WS_H = 62 * MiB;
constexpr size_t WS_GR = 114 * MiB;
constexpr size_t WS_GQ = 146 * MiB;
constexpr size_t WS_GOQ = 178 * MiB;
constexpr size_t WS_OGDN = 194 * MiB;
constexpr size_t WS_HN2 = 210 * MiB;
constexpr size_t WS_OGLA = 226 * MiB;
constexpr size_t WS_YS5 = 242 * MiB;
constexpr size_t WS_GLADS = 258 * MiB;
constexpr size_t WS_GLASC = 266 * MiB;
constexpr size_t WS_GLADV = 274 * MiB;
constexpr size_t WS_S5E = 275 * MiB;
constexpr size_t WS_S5HS = 277 * MiB;
constexpr size_t WS_GEGL = 279 * MiB;
constexpr size_t WS_WGLU = 279 * MiB + 512 * 1024;
constexpr size_t WS_END = 280 * MiB;
constexpr int CW_BAR = 4096;
constexpr size_t WS_SUBBAR = 48 * 1024;
constexpr size_t WS_SS = 64 * 1024;
constexpr size_t WS_CW = WS_MOD + 256 * 1024;
constexpr size_t WS_BGU = WS_MOD + 512 * 1024;
constexpr size_t WS_BIN = WS_BGU + 2 * 3 * 5632 * 4;
constexpr int LDS_BYTES = 152 * 1024;
constexpr int LDS_CTL_OFF = 150 * 1024;

#define RLX_AGENT __ATOMIC_RELAXED, __HIP_MEMORY_SCOPE_AGENT
#if defined(__HIP_DEVICE_COMPILE__)
#define ASSUME_GLOBAL(p) __builtin_assume(!__builtin_amdgcn_is_shared((const void*)(p)) && !__builtin_amdgcn_is_private((const void*)(p)))
#else
#define ASSUME_GLOBAL(p) ((void)0)
#endif
__device__ __forceinline__ unsigned f2bf(float f) { unsigned u = __builtin_bit_cast(unsigned, f); return (u + 0x7fffu + ((u >> 16) & 1u)) >> 16; }
__device__ __forceinline__ unsigned pk2(float lo, float hi) { return f2bf(lo) | (f2bf(hi) << 16); }
__device__ __forceinline__ float bf2f(unsigned short h) { return __builtin_bit_cast(float, (unsigned)h << 16); }
__device__ __forceinline__ float bflo(unsigned u) { return __builtin_bit_cast(float, u << 16); }
__device__ __forceinline__ float bfhi(unsigned u) { return __builtin_bit_cast(float, u & 0xffff0000u); }
__device__ __forceinline__ float siluf(float x) { return x / (1.0f + __expf(-x)); }
__device__ __forceinline__ float sigmf(float x) { return 1.0f / (1.0f + __expf(-x)); }
__device__ __forceinline__ float softplusf(float x) { return fmaxf(x, 0.f) + log1pf(__expf(-fabsf(x))); }
__device__ __forceinline__ float wave_sum(float v) {
#pragma unroll
    for (int o = 1; o < 64; o <<= 1) v += __shfl_xor(v, o);
    return v;
}

struct Args { const float* in[34]; float* out; unsigned char* ws; int ph_lo, ph_hi; };
__device__ __forceinline__ float lane_read(float v, int src_lane) { return __builtin_bit_cast(float, __builtin_amdgcn_ds_bpermute(src_lane << 2, __builtin_bit_cast(int, v))); }
struct Ctx {
    LAS unsigned char* lds;
    int tid, lane, wave, vb, nb, vb_raw;
    unsigned char* ws; float* out;
    __device__ __forceinline__ unsigned long long ptab(int i) const { const volatile LAS unsigned* p = (const volatile LAS unsigned*)(lds + LDS_CTL_OFF + 256) + 2 * i;
        const unsigned lo = __builtin_amdgcn_readfirstlane(p[0]), hi = __builtin_amdgcn_readfirstlane(p[1]); return ((unsigned long long)hi << 32) | lo; }
    __device__ __forceinline__ const float* inp(int i) const { return (const float*)(GAS const float*)ptab(i); }
    __device__ __forceinline__ float* outp() const { return out; }
    __device__ __forceinline__ float* wsf(size_t off) const { return (float*)(ws + off); }
    __device__ __forceinline__ bf16* wsb(size_t off) const { return (bf16*)(ws + off); }
};
enum { I_XP = 0, I_XS, I_C, I_SGLA, I_SGDN, I_S5RE, I_S5IM, I_CCTX, I_WADA, I_BADA, I_NORMW, I_WG, I_WU, I_WDN, I_WIN, I_GKUP, I_GKB, I_GLANW, I_CONVW, I_ALOG, I_DTB, I_GDNNW,
       I_LRE, I_LIM, I_LSTEP, I_BRE, I_BIM, I_CRE, I_CIM, I_S5D, I_WGLU, I_BGLU, I_WOUT, I_FNW };

struct ChunkInfo { int row0, seq, c, nc, lat, clo, chi, gc0; };
__device__ __forceinline__ ChunkInfo chunk_info(int gc) {
    ChunkInfo ci; ci.row0 = gc * 64;
    if (gc < 64) { ci.seq = gc >> 2; ci.c = gc & 3; ci.nc = 4; ci.lat = 0; ci.clo = ci.seq * 256; ci.chi = ci.clo + 256; ci.gc0 = ci.seq * 4; }
    else { ci.seq = 16 + ((gc - 64) >> 5); ci.c = (gc - 64) & 31; ci.nc = 32; ci.lat = 1; ci.clo = ci.row0; ci.chi = ci.row0 + 64; ci.gc0 = 64 + (ci.seq - 16) * 32; }
    return ci;
}
__device__ __forceinline__ int row_cid(int row) { return row < MCTX ? 0 : 1 + ((row - MCTX) >> 11); }

__device__ __forceinline__ void load16bf(const bf16* p, float (&x)[16]) {
    const v4u a = *(const v4u*)p, b = *(const v4u*)(p + 8);
    x[0] = bflo(a.x); x[1] = bfhi(a.x); x[2] = bflo(a.y); x[3] = bfhi(a.y); x[4] = bflo(a.z); x[5] = bfhi(a.z); x[6] = bflo(a.w); x[7] = bfhi(a.w);
    x[8] = bflo(b.x); x[9] = bfhi(b.x); x[10] = bflo(b.y); x[11] = bfhi(b.y); x[12] = bflo(b.z); x[13] = bfhi(b.z); x[14] = bflo(b.w); x[15] = bfhi(b.w);
}
__device__ __forceinline__ void ph_mod(Ctx& C) {
    LAS float* scond = (LAS float*)C.lds;
    LAS float* red = scond + 3072;
    for (int i = C.tid; i < 3072; i += NTHR) { const int cid = i >> 10, k = i & 1023; const float v = cid == 0 ? C.inp(I_CCTX)[k] : C.inp(I_C)[(cid - 1) * 1024 + k]; scond[i] = siluf(v); }
    __syncthreads();
    const float* wada = C.inp(I_WADA); const float* bada = C.inp(I_BADA);
    for (int unit = C.vb; unit < 288; unit += C.nb) {
        const int l = unit / 144, cb = (unit % 144) * 64, col = cb + C.lane;
        const float* w = wada + (size_t)l * 1024 * 9216 + col;
        float a0 = 0.f, a1 = 0.f, a2 = 0.f; const int k0 = C.wave * 128;
#pragma unroll 8
        for (int k = k0; k < k0 + 128; ++k) { const float wv = w[(size_t)k * 9216]; a0 += scond[k] * wv; a1 += scond[1024 + k] * wv; a2 += scond[2048 + k] * wv; }
        red[(C.wave * 3 + 0) * 64 + C.lane] = a0; red[(C.wave * 3 + 1) * 64 + C.lane] = a1; red[(C.wave * 3 + 2) * 64 + C.lane] = a2;
        __syncthreads();
        if (C.tid < 192) { const int cid = C.tid >> 6, ln = C.tid & 63; float s = bada[l * 9216 + cb + ln];
#pragma unroll
            for (int w8 = 0; w8 < 8; ++w8) s += red[(w8 * 3 + cid) * 64 + ln];
            C.wsf(WS_MOD)[(l * 3 + cid) * 9216 + cb + ln] = s;
            const int chunk = cb >> 10; if (chunk % 3 == 1) { const int inst = chunk / 3, col = (cb & 1023) + ln; C.wsf(WS_CW)[((l * 3 + inst) * 3 + cid) * D + col] = C.inp(I_NORMW)[(l * 3 + inst) * D + col] * (1.f + s); } }
        __syncthreads();
    }
}

template <int MODE>
__device__ __forceinline__ void transpose_item(const float* W, int K, int N, int NPAD, bf16* WT, LAS float* scr, int item, int lane) {
    const int nblk = NPAD / 32, kb = item / nblk, nbk = item % nblk, k0 = 64 * kb, n0 = 32 * nbk;
#pragma unroll 8
    for (int i = 0; i < 32; ++i) { const int kk = 2 * i + (lane >> 5), n = n0 + (lane & 31); scr[kk * 33 + (lane & 31)] = (n < N) ? W[(size_t)(k0 + kk) * N + n] : 0.f; }
    asm volatile("s_waitcnt lgkmcnt(0)" ::: "memory");
    const int c = lane & 7;
#pragma unroll
    for (int j = 0; j < 4; ++j) { const int nn = (lane >> 3) + 8 * j; const LAS float* s = scr + (8 * c) * 33 + nn;
        v4u o; o.x = pk2(s[0 * 33], s[1 * 33]); o.y = pk2(s[2 * 33], s[3 * 33]); o.z = pk2(s[4 * 33], s[5 * 33]); o.w = pk2(s[6 * 33], s[7 * 33]);
        const int n = n0 + nn; const int row = MODE == 0 ? n : (MODE == 1 ? 8 * (n >> 2) + (n & 3) : 8 * (n >> 2) + 4 + (n & 3));
        *(v4u*)(WT + (size_t)row * K + k0 + 8 * c) = o; }
    asm volatile("s_waitcnt lgkmcnt(0)" ::: "memory");
}
__device__ __forceinline__ void ph_wconv(Ctx& C, int l) {
    LAS float* scr = (LAS float*)(C.lds + C.wave * 8448);
    const int gw = C.vb * NWAVES + C.wave, NGW = C.nb * NWAVES;
    constexpr int I_G = 16 * 88, I_D = 44 * 32, I_IN = 16 * 104, I_O = 16 * 32, I_GL = 4 * 8;
    constexpr int NITEMS = 4 * I_G + 2 * I_D + I_IN + I_O + I_GL;
    for (int it = gw; it < NITEMS; it += NGW) {
        int r = it;
        if (r < 4 * I_G) { const int j = r / (2 * I_G), gu = (r / I_G) & 1; r %= I_G;
            const float* W = C.inp(gu ? I_WU : I_WG) + (size_t)(l * 2 + j) * D * FF; bf16* WT = C.wsb(WS_WGU) + (size_t)j * NGU * D;
            if (gu) transpose_item<2>(W, D, FF, FF, WT, scr, r, C.lane); else transpose_item<1>(W, D, FF, FF, WT, scr, r, C.lane); continue; }
        r -= 4 * I_G;
        if (r < 2 * I_D) { const int j = r / I_D; r %= I_D; transpose_item<0>(C.inp(I_WDN) + (size_t)(l * 2 + j) * FF * D, FF, D, D, C.wsb(WS_WD) + (size_t)j * D * FF, scr, r, C.lane); continue; }
        r -= 2 * I_D;
        if (r < I_IN) { transpose_item<0>(C.inp(I_WIN) + (size_t)l * D * NIN, D, NIN, NINP, C.wsb(WS_WIN), scr, r, C.lane); continue; }
        r -= I_IN;
        if (r < I_O) { transpose_item<0>(C.inp(I_WOUT) + (size_t)l * D * D, D, D, D, C.wsb(WS_WOUT), scr, r, C.lane); continue; }
        r -= I_O;
        transpose_item<0>(C.inp(I_WGLU) + (size_t)l * 65536, 256, 256, 256, C.wsb(WS_WGLU), scr, r, C.lane);
    }
}

__device__ __forceinline__ void ph_bias(Ctx& C, int l) {
    const int gw = C.vb * NWAVES + C.wave, NGW = C.nb * NWAVES, lane = C.lane;
    const float* MOD = C.wsf(WS_MOD);
    for (int part = 0; part < 3; ++part) {
        const int inst = part == 0 ? 0 : (part == 1 ? 2 : 1), nrows = part < 2 ? NGU : NINP;
        const bf16* W = part < 2 ? C.wsb(WS_WGU) + (size_t)part * NGU * D : C.wsb(WS_WIN);
        float* out = part < 2 ? C.wsf(WS_BGU) + (size_t)part * 3 * NGU : C.wsf(WS_BIN);
        float sh[3][16];
#pragma unroll
        for (int cid = 0; cid < 3; ++cid)
#pragma unroll
            for (int k = 0; k < 4; ++k) { const f32x4 v = *(const f32x4*)(MOD + (l * 3 + cid) * 9216 + (inst * 3) * D + lane * 16 + 4 * k); sh[cid][4 * k] = v.x; sh[cid][4 * k + 1] = v.y; sh[cid][4 * k + 2] = v.z; sh[cid][4 * k + 3] = v.w; }
        for (int n = gw; n < nrows; n += NGW) { float w[16]; load16bf(W + (size_t)n * D + lane * 16, w);
            float a0 = 0.f, a1 = 0.f, a2 = 0.f;
#pragma unroll
            for (int k = 0; k < 16; ++k) { a0 += w[k] * sh[0][k]; a1 += w[k] * sh[1][k]; a2 += w[k] * sh[2][k]; }
            a0 = wave_sum(a0); a1 = wave_sum(a1); a2 = wave_sum(a2);
            if (lane == 0) { out[n] = a0; out[nrows + n] = a1; out[2 * nrows + n] = a2; } }
    }
}
__device__ __forceinline__ void ph_xb0(Ctx& C) {
    const int gw = C.vb * NWAVES + C.wave, NGW = C.nb * NWAVES;
    const float* x0 = C.inp(I_XP); const float* x1 = C.inp(I_XS); bf16* HN = C.wsb(WS_HN); float* SS = (float*)(C.ws + WS_SS); const float* CW = C.wsf(WS_CW);
    for (int m = gw; m < M; m += NGW) {
        const int cid = row_cid(m); const float* xr = m < MCTX ? x0 + (size_t)m * D : x1 + (size_t)(m - MCTX) * D; const float* cw = CW + cid * D;
        float ss = 0.f;
#pragma unroll
        for (int j = 0; j < 4; ++j) { const int c0 = C.lane * 4 + 256 * j; const f32x4 v = *(const f32x4*)(xr + c0), w4 = *(const f32x4*)(cw + c0);
            ss += (v.x * v.x + v.y * v.y) + (v.z * v.z + v.w * v.w);
            v2u o; o.x = pk2(v.x * w4.x, v.y * w4.y); o.y = pk2(v.z * w4.z, v.w * w4.w); *(v2u*)(HN + (size_t)m * D + c0) = o; }
        ss = wave_sum(ss); if (C.lane == 0) SS[m] = ss;
    }
}
__device__ __forceinline__ void ph_final(Ctx& C) {
    const int gw = C.vb * NWAVES + C.wave, NGW = C.nb * NWAVES;
    const float* nw = C.inp(I_FNW);
    for (int m = gw; m < M; m += NGW) {
        float* xr = C.outp() + (size_t)m * D;
        f32x4 v[4]; float ss = 0.f;
#pragma unroll
        for (int j = 0; j < 4; ++j) { v[j] = *(const f32x4*)(xr + C.lane * 4 + 256 * j); ss += (v[j].x * v[j].x + v[j].y * v[j].y) + (v[j].z * v[j].z + v[j].w * v[j].w); }
        const float rstd = 1.0f / sqrtf(wave_sum(ss) * (1.f / D) + 1e-6f);
#pragma unroll
        for (int j = 0; j < 4; ++j) { const int c0 = C.lane * 4 + 256 * j; const f32x4 w4 = *(const f32x4*)(nw + c0);
            f32x4 o; o.x = v[j].x * rstd * w4.x; o.y = v[j].y * rstd * w4.y; o.z = v[j].z * rstd * w4.z; o.w = v[j].w * rstd * w4.w; *(f32x4*)(xr + c0) = o; }
    }
}

namespace pg8 {
struct EpiGU {
    static constexpr bool PERM = true, AFTER_DRAIN = false;
    bf16_t* Hout; const PG8_LAS float* ep;
    __device__ __forceinline__ void operator()(const f32x4 (&acc)[2][2][4][2], const Unit& u, int wr, int wc, int fr, int fq) const {
        const int row0 = u.pm * BM + wr * 64 + fr, hcol0 = u.pn * 128 + wc * 16 + 4 * fq;
        const PG8_LAS float* e = ep + u.idx * 512;
        f32x4 bg[2], bu[2];
#pragma unroll
        for (int bj = 0; bj < 2; ++bj) { bg[bj] = *(const PG8_LAS f32x4*)(e + 256 + wc * 32 + 8 * fq + bj * HALF); bu[bj] = *(const PG8_LAS f32x4*)(e + 256 + wc * 32 + 8 * fq + bj * HALF + 4); }
#pragma unroll
        for (int ai = 0; ai < 2; ++ai)
#pragma unroll
            for (int m = 0; m < 4; ++m) { const int rl = wr * 64 + fr + ai * HALF + m * 16; const float rs = e[rl]; bf16_t* rowp = Hout + (size_t)(u.pm * BM + rl) * FF + hcol0;
#pragma unroll
                for (int bj = 0; bj < 2; ++bj) { const f32x4 g = acc[ai][bj][m][0] * rs + bg[bj], uu = acc[ai][bj][m][1] * rs + bu[bj];
                    v2u w; w.x = cvt_pk_bf16(siluf(g[0]) * uu[0], siluf(g[1]) * uu[1]); w.y = cvt_pk_bf16(siluf(g[2]) * uu[2], siluf(g[3]) * uu[3]);
                    *(v2u*)(rowp + bj * 64) = w; } }
    }
};
template <bool NB1> struct EpiRes {
    static constexpr bool PERM = false, AFTER_DRAIN = false;
    const float* base0; const float* base1; float* X; bf16_t* XB; float* SS; const float* cw; const float* gate; float scale;
    __device__ __forceinline__ void operator()(const f32x4 (&acc)[2][2][4][2], const Unit& u, int wr, int wc, int fr, int fq) const {
        const int row0 = u.pm * BM + wr * 64 + fr, col0 = u.pn * (NB1 ? HALF : BM) + wc * 32 + 4 * fq; constexpr int NBJ = NB1 ? 1 : 2;
        const int cid = u.pm < 16 ? 0 : 1 + ((u.pm - 16) >> 3);
        f32x4 gv[2][2], cv[2][2];
#pragma unroll
        for (int bj = 0; bj < NBJ; ++bj)
#pragma unroll
            for (int n = 0; n < 2; ++n) { gv[bj][n] = *(const f32x4*)(gate + cid * 9216 + col0 + bj * HALF + n * 16) * scale; cv[bj][n] = cw ? *(const f32x4*)(cw + cid * D + col0 + bj * HALF + n * 16) : (f32x4){0.f, 0.f, 0.f, 0.f}; }
#pragma unroll
        for (int ai = 0; ai < 2; ++ai)
#pragma unroll
            for (int m = 0; m < 4; ++m) { const int row = row0 + ai * HALF + m * 16;
                const float* bp = (row < MCTX ? base0 + (size_t)row * D : base1 + (size_t)(row - MCTX) * D) + col0; float* xp = X + (size_t)row * D + col0; float ss = 0.f;
#pragma unroll
                for (int bj = 0; bj < NBJ; ++bj)
#pragma unroll
                    for (int n = 0; n < 2; ++n) { const f32x4 xn = *(const f32x4*)(bp + bj * HALF + n * 16) + gv[bj][n] * acc[ai][bj][m][n]; *(f32x4*)(xp + bj * HALF + n * 16) = xn;
                        if (cw) { ss += (xn[0] * xn[0] + xn[1] * xn[1]) + (xn[2] * xn[2] + xn[3] * xn[3]); const f32x4 y = xn * cv[bj][n];
                            v2u o; o.x = cvt_pk_bf16(y[0], y[1]); o.y = cvt_pk_bf16(y[2], y[3]); *(v2u*)(XB + (size_t)row * D + col0 + bj * HALF + n * 16) = o; } }
                if (cw) { ss += __shfl_xor(ss, 16); ss += __shfl_xor(ss, 32); if (fq == 0) atomicAdd(SS + row, ss); } }
    }
};
struct EpiProj {
    static constexpr bool PERM = true, AFTER_DRAIN = false;
    bf16_t* O; int ldc; const PG8_LAS float* ep;
    __device__ __forceinline__ void operator()(const f32x4 (&acc)[2][2][4][2], const Unit& u, int wr, int wc, int fr, int fq) const {
        const int col0 = u.pn * BM + wc * 32 + 8 * fq;
        const PG8_LAS float* e = ep + u.idx * 512;
        f32x4 b0[2], b1[2];
#pragma unroll
        for (int bj = 0; bj < 2; ++bj) { b0[bj] = *(const PG8_LAS f32x4*)(e + 256 + wc * 32 + 8 * fq + bj * HALF); b1[bj] = *(const PG8_LAS f32x4*)(e + 256 + wc * 32 + 8 * fq + bj * HALF + 4); }
#pragma unroll
        for (int ai = 0; ai < 2; ++ai)
#pragma unroll
            for (int m = 0; m < 4; ++m) { const int rl = wr * 64 + fr + ai * HALF + m * 16; const float rs = e[rl]; bf16_t* rowp = O + (size_t)(u.pm * BM + rl) * ldc + col0;
#pragma unroll
                for (int bj = 0; bj < 2; ++bj) { const f32x4 v0 = acc[ai][bj][m][0] * rs + b0[bj], v1 = acc[ai][bj][m][1] * rs + b1[bj];
                    u32x4 w; w.x = cvt_pk_bf16(v0[0], v0[1]); w.y = cvt_pk_bf16(v0[2], v0[3]); w.z = cvt_pk_bf16(v1[0], v1[1]); w.w = cvt_pk_bf16(v1[2], v1[3]);
                    *(u32x4*)(rowp + bj * HALF) = w; } }
    }
};
}

__device__ __forceinline__ void lds8bf(const LAS bf16* p, float (&x)[8]) {
    const v4u a = *(const LAS v4u*)p;
    x[0] = bflo(a.x); x[1] = bfhi(a.x); x[2] = bflo(a.y); x[3] = bfhi(a.y); x[4] = bflo(a.z); x[5] = bfhi(a.z); x[6] = bflo(a.w); x[7] = bfhi(a.w);
}

typedef short bf16x8 __attribute__((ext_vector_type(8)));
#define MFMA16(a, b, c) __builtin_amdgcn_mfma_f32_16x16x32_bf16((a), (b), (c), 0, 0, 0)
__device__ __forceinline__ int t128_off(int row, int col) { return row * 256 + (((col >> 3) ^ (row & 15)) << 4) + (col & 7) * 2; }
__device__ __forceinline__ int t64_off(int row, int col) { return row * 128 + (((col >> 3) ^ ((row >> 1) & 7)) << 4) + (col & 7) * 2; }
__device__ __forceinline__ int lo64(int lane, int ks) { const int r = lane & 15, q = lane >> 4; return r * 128 + (((4 * ks + q) ^ ((r >> 1) & 7)) << 4); }
__device__ __forceinline__ int lo128(int lane, int ks) { const int r = lane & 15, q = lane >> 4; return r * 256 + (((4 * ks + q) ^ r) << 4); }
__device__ __forceinline__ bf16x8 frag128(const LAS unsigned char* T, int r0, int k0, int lane) { return *(const LAS bf16x8*)(T + r0 * 256 + lo128(lane, k0 >> 5)); }
__device__ __forceinline__ bf16x8 frag64(const LAS unsigned char* T, int r0, int k0, int lane) { return *(const LAS bf16x8*)(T + r0 * 128 + lo64(lane, k0 >> 5)); }

__device__ __forceinline__ void gdn_inverse_blk(LAS unsigned char* Lb, int L0off, int TKoff, const LAS float* SG, int tid) {
    const int d = tid >> 8, tl = tid & 255, wl = __builtin_amdgcn_readfirstlane(tl >> 6), lane = tid & 63, q = lane >> 4, c = lane & 15;
    const LAS float* Lm = (const LAS float*)(Lb + L0off + d * 16384);
    LAS float* Tf = (LAS float*)(Lb + TKoff + d * 16384);
    {
        const LAS float* Ld = Lm + (wl * 16) * 64 + wl * 16; float x[16];
#pragma unroll
        for (int i = 0; i < 16; ++i) { float a = (i == c) ? 1.f : 0.f;
#pragma unroll
            for (int j = 0; j < i; ++j) a -= Ld[i * 64 + j] * x[j];
            x[i] = a; }
#pragma unroll
        for (int i = 0; i < 16; ++i) Tf[(wl * 16 + i) * 64 + wl * 16 + c] = x[i]; }
    __syncthreads();
#pragma unroll
    for (int dist = 1; dist < 4; ++dist) {
        if (wl + dist < 4) { const int j = wl, i = wl + dist;
            f32x4 P = {0.f, 0.f, 0.f, 0.f};
            for (int k = j; k < i; ++k) {
#pragma unroll
                for (int ks = 0; ks < 4; ++ks) P = __builtin_amdgcn_mfma_f32_16x16x4f32(Lm[(i * 16 + c) * 64 + k * 16 + 4 * ks + q], Tf[(k * 16 + 4 * ks + q) * 64 + j * 16 + c], P, 0, 0, 0); }
            f32x4 T = {0.f, 0.f, 0.f, 0.f};
#pragma unroll
            for (int ks = 0; ks < 4; ++ks) T = __builtin_amdgcn_mfma_f32_16x16x4f32(-Tf[(i * 16 + c) * 64 + i * 16 + 4 * q + ks], P[ks], T, 0, 0, 0);
#pragma unroll
            for (int r = 0; r < 4; ++r) Tf[(i * 16 + 4 * q + r) * 64 + j * 16 + c] = T[r]; }
        __syncthreads();
    }
    float vals[16];
#pragma unroll
    for (int k = 0; k < 16; ++k) { const int idx = tl + 256 * k, u = idx >> 6, v = idx & 63; vals[k] = ((v >> 4) <= (u >> 4)) ? Tf[u * 64 + v] : 0.f; }
    __syncthreads();
    LAS unsigned char* TK = Lb + TKoff + d * 16384; LAS unsigned char* TV = TK + 8192;
#pragma unroll
    for (int k = 0; k < 16; ++k) { const int idx = tl + 256 * k, u = idx >> 6, v = idx & 63, t = d ? 63 - u : u, sidx = d ? 63 - v : v;
        const float sv = SG[128 + d * 64 + sidx], sk = sv * SG[256 + d * 64 + sidx];
        *(LAS bf16*)(TK + t64_off(t, sidx)) = (bf16)f2bf(vals[k] * sk); *(LAS bf16*)(TV + t64_off(t, sidx)) = (bf16)f2bf(vals[k] * sv); }
}

__device__ __forceinline__ void gdn_prep_item(Ctx& C, int l, int gc, int h) {
    LAS unsigned char* L = C.lds;
    constexpr int QB = 0, KB = 16384, KT = 32768, VT = 49152, L0 = 65536, L1 = 81920, WT = 65536, UT = 81920, QKM0 = 98304, TK0 = 114688, SGO = 147456;
    LAS float* SG = (LAS float*)(L + SGO);
    const ChunkInfo ci = chunk_info(gc);
    int tid = C.tid; asm volatile("" : "+v"(tid));
    const int lane = tid & 63, w = C.wave, q = lane >> 4, c = lane & 15;
    const bf16* PROJ = C.wsb(WS_PROJ);
    {
        const int t = tid >> 3, sub = tid & 7, d0 = sub * 16, row = ci.row0 + t;
        const float* cwb = C.inp(I_CONVW) + (size_t)l * 5 * 1536 + h * 128 + d0;
        float msk[5]; int rcl[5];
#pragma unroll
        for (int j = 0; j < 5; ++j) { const int r = row + j - 2; msk[j] = (r >= ci.clo && r < ci.chi) ? 1.f : 0.f; rcl[j] = r < ci.clo ? ci.clo : (r >= ci.chi ? ci.chi - 1 : r); }
        v4u xa[5][2], xb[5][2];
#define GP_LOAD(X, which) { _Pragma("unroll") for (int j = 0; j < 5; ++j) { const bf16* pr = PROJ + (size_t)rcl[j] * NINP + C_DQ + (which) * 512 + h * 128 + d0; X[j][0] = *(const v4u*)pr; X[j][1] = *(const v4u*)(pr + 8); } }
#define GP_REDUCE(X, which) { float ax[16]; \
            _Pragma("unroll") for (int i = 0; i < 16; ++i) ax[i] = 0.f; \
            _Pragma("unroll") for (int j = 0; j < 5; ++j) { const float m = msk[j]; const float* cw = cwb + j * 1536 + (which) * 512; \
                _Pragma("unroll") for (int hc = 0; hc < 2; ++hc) { const v4u x = X[j][hc]; const f32x4 w0 = *(const f32x4*)(cw + 8 * hc), w1 = *(const f32x4*)(cw + 8 * hc + 4); \
                    ax[8 * hc + 0] += m * bflo(x.x) * w0.x; ax[8 * hc + 1] += m * bfhi(x.x) * w0.y; ax[8 * hc + 2] += m * bflo(x.y) * w0.z; ax[8 * hc + 3] += m * bfhi(x.y) * w0.w; \
                    ax[8 * hc + 4] += m * bflo(x.z) * w1.x; ax[8 * hc + 5] += m * bfhi(x.z) * w1.y; ax[8 * hc + 6] += m * bflo(x.w) * w1.z; ax[8 * hc + 7] += m * bfhi(x.w) * w1.w; } } \
            float ss = 0.f; \
            _Pragma("unroll") for (int i = 0; i < 16; ++i) { ax[i] = siluf(ax[i]); ss += ax[i] * ax[i]; } \
            ss += lane_read(ss, lane ^ 1); ss += lane_read(ss, lane ^ 2); ss += lane_read(ss, lane ^ 4); \
            const float sc = (which) == 0 ? 0.08838834764831845f / sqrtf(ss + 1e-6f) : ((which) == 1 ? 1.0f / sqrtf(ss + 1e-6f) : 1.0f); \
            _Pragma("unroll") for (int i = 0; i < 16; ++i) ax[i] *= sc; \
            if ((which) < 2) { _Pragma("unroll") for (int hc = 0; hc < 2; ++hc) { const int off = t * 256 + (((2 * sub + hc) ^ (t & 15)) << 4); \
                    v4u a; a.x = pk2(ax[8 * hc], ax[8 * hc + 1]); a.y = pk2(ax[8 * hc + 2], ax[8 * hc + 3]); a.z = pk2(ax[8 * hc + 4], ax[8 * hc + 5]); a.w = pk2(ax[8 * hc + 6], ax[8 * hc + 7]); \
                    *(LAS v4u*)(L + ((which) ? KB : QB) + off) = a; } } \
            if ((which) > 0) { _Pragma("unroll") for (int i = 0; i < 16; ++i) *(LAS bf16*)(L + ((which) == 1 ? KT : VT) + t64_off(d0 + i, t)) = (bf16)f2bf(ax[i]); } }
        GP_LOAD(xa, 0) GP_LOAD(xb, 1)
        GP_REDUCE(xa, 0)
        GP_LOAD(xa, 2)
        GP_REDUCE(xb, 1)
        GP_REDUCE(xa, 2)
#undef GP_LOAD
#undef GP_REDUCE
    }
    if (tid < 128) {
        const int d = tid >> 6, t = tid & 63; const bf16* pr = PROJ + (size_t)(ci.row0 + t) * NINP;
        const float a_raw = bf2f(pr[(d ? C_DAB : C_DAF) + h]), b_raw = bf2f(pr[(d ? C_DBB : C_DBF) + h]);
        const float la = -__expf(C.inp(I_ALOG)[(l * 2 + d) * 4 + h]) * softplusf(a_raw + C.inp(I_DTB)[(l * 2 + d) * 4 + h]);
        float ps = la;
#pragma unroll
        for (int off = 1; off < 64; off <<= 1) { const float v = lane_read(ps, t >= off ? t - off : t); if (t >= off) ps += v; }
        const float tot = lane_read(ps, 63), g = d ? (tot - ps + la) : ps;
        SG[d * 64 + t] = g; SG[128 + d * 64 + t] = sigmf(b_raw); SG[256 + d * 64 + t] = __expf(g); SG[384 + d * 64 + t] = __expf(tot - g);
        if (t == 0) SG[512 + d] = __expf(tot); }
    __syncthreads();
    {
        int lane = C.lane; asm volatile("" : "+v"(lane)); const int q = lane >> 4, c = lane & 15;
        const int mt = w & 3; const bool isq = w >= 4;
        f32x4 acc[4];
#pragma unroll
        for (int nt = 0; nt < 4; ++nt) acc[nt] = (f32x4){0.f, 0.f, 0.f, 0.f};
#pragma unroll
        for (int ks = 0; ks < 4; ++ks) { const bf16x8 a = frag128(L + (isq ? QB : KB), mt * 16, ks * 32, lane);
#pragma unroll
            for (int nt = 0; nt < 4; ++nt) acc[nt] = MFMA16(a, frag128(L + KB, nt * 16, ks * 32, lane), acc[nt]); }
#pragma unroll
        for (int nt = 0; nt < 4; ++nt)
#pragma unroll
            for (int r = 0; r < 4; ++r) { const int t = mt * 16 + 4 * q + r, s = nt * 16 + c; const float v = acc[nt][r];
                const float e0 = (s <= t) ? __expf(SG[t] - SG[s]) : 0.f, e1 = (s >= t) ? __expf(SG[64 + t] - SG[64 + s]) : 0.f;
                if (!isq) { ((LAS float*)(L + L0))[t * 64 + s] = (s < t) ? SG[128 + t] * e0 * v : 0.f; ((LAS float*)(L + L1))[(63 - t) * 64 + (63 - s)] = (s > t) ? SG[192 + t] * e1 * v : 0.f; }
                else { *(LAS bf16*)(L + QKM0 + t64_off(t, s)) = (bf16)f2bf(e0 * v); *(LAS bf16*)(L + QKM0 + 8192 + t64_off(t, s)) = (bf16)f2bf(e1 * v); } }
    }
    __syncthreads();
    gdn_inverse_blk(L, L0, TK0, SG, tid);
    __syncthreads();
    for (int d = 0; d < 2; ++d) {
        const int pid = (gc * 4 + h) * 2 + d;
        const LAS unsigned char* TKd = L + TK0 + d * 16384; const LAS unsigned char* TVd = TKd + 8192; const LAS unsigned char* QKMd = L + QKM0 + d * 8192;
        {
            int lane = C.lane; asm volatile("" : "+v"(lane)); const int q = lane >> 4, c = lane & 15;
            f32x4 aw[4], au[4];
#pragma unroll
            for (int nt = 0; nt < 4; ++nt) { aw[nt] = (f32x4){0.f, 0.f, 0.f, 0.f}; au[nt] = (f32x4){0.f, 0.f, 0.f, 0.f}; }
#pragma unroll
            for (int ks = 0; ks < 2; ++ks) { const bf16x8 ak = frag64(L + KT, w * 16, ks * 32, lane), av = frag64(L + VT, w * 16, ks * 32, lane);
#pragma unroll
                for (int nt = 0; nt < 4; ++nt) { aw[nt] = MFMA16(ak, frag64(TKd, nt * 16, ks * 32, lane), aw[nt]); au[nt] = MFMA16(av, frag64(TVd, nt * 16, ks * 32, lane), au[nt]); } }
#pragma unroll
            for (int nt = 0; nt < 4; ++nt)
#pragma unroll
                for (int r = 0; r < 4; ++r) { const int dd = w * 16 + 4 * q + r, i = nt * 16 + c;
                    *(LAS bf16*)(L + WT + t64_off(dd, i)) = (bf16)f2bf(aw[nt][r]); *(LAS bf16*)(L + UT + t64_off(dd, i)) = (bf16)f2bf(au[nt][r]); }
#pragma unroll
            for (int it = 0; it < 2; ++it) { const int idx = tid + it * NTHR, a = idx >> 3, ch = idx & 7, off = a * 128 + ((ch ^ ((a >> 1) & 7)) << 4);
                const v4u x = *(const LAS v4u*)(L + KT + off); const LAS float* cd = SG + 384 + d * 64 + ch * 8;
                v4u o; o.x = pk2(bflo(x.x) * cd[0], bfhi(x.x) * cd[1]); o.y = pk2(bflo(x.y) * cd[2], bfhi(x.y) * cd[3]); o.z = pk2(bflo(x.z) * cd[4], bfhi(x.z) * cd[5]); o.w = pk2(bflo(x.w) * cd[6], bfhi(x.w) * cd[7]);
                *(LAS v4u*)(L + KB + off) = o; }
        }
        __syncthreads();
        {
            int lane = C.lane; asm volatile("" : "+v"(lane)); const int q = lane >> 4, c = lane & 15;
            bf16x8 bq[4][2];
#pragma unroll
            for (int nt = 0; nt < 4; ++nt)
#pragma unroll
                for (int ks = 0; ks < 2; ++ks) bq[nt][ks] = frag64(QKMd, nt * 16, ks * 32, lane);
            f32x4 ao[4], al[4];
#pragma unroll
            for (int nt = 0; nt < 4; ++nt) { ao[nt] = (f32x4){0.f, 0.f, 0.f, 0.f}; al[nt] = (f32x4){0.f, 0.f, 0.f, 0.f}; }
#pragma unroll
            for (int ks = 0; ks < 2; ++ks) { const bf16x8 a1 = frag64(L + WT, w * 16, ks * 32, lane), a2 = frag64(L + UT, w * 16, ks * 32, lane);
#pragma unroll
                for (int nt = 0; nt < 4; ++nt) { ao[nt] = MFMA16(a1, bq[nt][ks], ao[nt]); al[nt] = MFMA16(a2, bq[nt][ks], al[nt]); } }
            bf16* goq = C.wsb(WS_GOQ) + (size_t)pid * 8192; bf16* ogdn = C.wsb(WS_OGDN) + ((size_t)d * M + ci.row0) * 512 + h * 128 + w * 16 + 4 * q;
#pragma unroll
            for (int nt = 0; nt < 4; ++nt) { const int i = nt * 16 + c; const float egi = SG[256 + d * 64 + i];
                const v2u qv = *(const LAS v2u*)(L + QB + t128_off(i, w * 16 + 4 * q));
                v2u o; o.x = pk2(egi * bflo(qv.x) - ao[nt][0], egi * bfhi(qv.x) - ao[nt][1]); o.y = pk2(egi * bflo(qv.y) - ao[nt][2], egi * bfhi(qv.y) - ao[nt][3]);
                *(v2u*)(goq + ((nt * 4 + (w >> 1)) * 64 + q * 16 + c) * 8 + 4 * (w & 1)) = o;
                v2u ol_; ol_.x = pk2(al[nt][0], al[nt][1]); ol_.y = pk2(al[nt][2], al[nt][3]); *(v2u*)(ogdn + (size_t)i * 512) = ol_; }
        }
#ifndef NO_RQ
        {
            int lane = C.lane; asm volatile("" : "+v"(lane)); const int q = lane >> 4, c = lane & 15;
            f32x4 ar[8], aq2[8];
#pragma unroll
            for (int nt = 0; nt < 8; ++nt) { ar[nt] = (f32x4){0.f, 0.f, 0.f, 0.f}; aq2[nt] = (f32x4){0.f, 0.f, 0.f, 0.f}; }
#pragma unroll
            for (int ks = 0; ks < 2; ++ks) { const bf16x8 a1 = frag64(L + WT, w * 16, ks * 32, lane), a2 = frag64(L + KB, w * 16, ks * 32, lane);
#pragma unroll
                for (int nt = 0; nt < 8; ++nt) { ar[nt] = MFMA16(a1, frag64(L + KB, nt * 16, ks * 32, lane), ar[nt]); aq2[nt] = MFMA16(a2, frag64(L + UT, nt * 16, ks * 32, lane), aq2[nt]); } }
            bf16* gr = C.wsb(WS_GR) + (size_t)pid * 16384; bf16* gq = C.wsb(WS_GQ) + (size_t)pid * 16384;
#pragma unroll
            for (int nt = 0; nt < 8; ++nt) { v2u o; o.x = pk2(-ar[nt][0], -ar[nt][1]); o.y = pk2(-ar[nt][2], -ar[nt][3]);
                *(v2u*)(gr + ((nt * 4 + (w >> 1)) * 64 + q * 16 + c) * 8 + 4 * (w & 1)) = o;
                v2u p; p.x = pk2(aq2[nt][0], aq2[nt][1]); p.y = pk2(aq2[nt][2], aq2[nt][3]);
                *(v2u*)(gq + ((nt * 8 + w) * 64 + lane) * 4) = p; }
        }
#endif
        if (tid == 0) C.wsf(WS_GEGL)[pid] = SG[512 + d];
        __syncthreads();
    }
}

struct ScanQo { v2u qv[8]; v2u ol[4]; float egl; };
__device__ __forceinline__ void gl16(v4u& d, const void* p) { asm volatile("global_load_dwordx4 %0, %1, off" : "=v"(d) : "v"(p) : "memory"); }
__device__ __forceinline__ void gl8(v2u& d, const void* p) { asm volatile("global_load_dwordx2 %0, %1, off" : "=v"(d) : "v"(p) : "memory"); }
template <int IMM> __device__ __forceinline__ void gl8s(v2u& d, unsigned voff, const void* sbase) { asm volatile("global_load_dwordx2 %0, %1, %2 offset:%3" : "=v"(d) : "v"(voff), "s"(sbase), "i"(IMM) : "memory"); }
__device__ __forceinline__ void gl4(float& d, const void* p) { asm volatile("global_load_dword %0, %1, off" : "=v"(d) : "v"(p) : "memory"); }
__device__ __forceinline__ void gdn_scan_unit(Ctx& C, int l, int seq, int h, int d, bool dry) {
    LAS unsigned char* L = C.lds;
    const int tid = C.tid, lane = C.lane, w = C.wave, q = lane >> 4, c = lane & 15;
    const int lat = seq >= 16, nc = lat ? 32 : 4, gc0 = lat ? 64 + (seq - 16) * 32 : seq * 4;
    const unsigned char* GRb = (const unsigned char*)C.wsb(WS_GR); const unsigned char* GOQb = (const unsigned char*)C.wsb(WS_GOQ);
    const bf16* GQp = C.wsb(WS_GQ); const float* GEGL = C.wsf(WS_GEGL); bf16* OG = C.wsb(WS_OGDN);
    f32x4 acc[8];
#pragma unroll
    for (int mt = 0; mt < 8; ++mt) acc[mt] = (f32x4){0.f, 0.f, 0.f, 0.f};
    if (lat) { const float* sp = C.inp(I_SGDN) + ((((size_t)(seq - 16) * 2 + l) * 2 + d) * 4 + h) * 16384 + w * 16 + c;
#pragma unroll
        for (int mt = 0; mt < 8; ++mt)
#pragma unroll
            for (int r = 0; r < 4; ++r) acc[mt][r] = sp[(size_t)(mt * 16 + 4 * q + r) * 128]; }
    asm volatile("s_waitcnt vmcnt(0)" ::: "memory");
#define SC_GC(n) (gc0 + (d ? nc - 1 - ((n) < nc ? (n) : nc - 1) : ((n) < nc ? (n) : nc - 1)))
#define SC_DMA(n) { const int pid_ = (SC_GC(n) * 4 + h) * 2 + d; LAS unsigned char* Bn_ = L + ((n) % 3) * 49152 + w * 1024; _Pragma("unroll") for (int k = 0; k < 6; ++k) \
        __builtin_amdgcn_global_load_lds((const unsigned*)(k < 4 ? GRb + (size_t)pid_ * 32768 + (k * NTHR + tid) * 16 : GOQb + (size_t)pid_ * 16384 + ((k - 4) * NTHR + tid) * 16), (LAS unsigned*)(Bn_ + k * 8192), 16, 0, 0); }
#define SC_WAIT_QO(Q, N) asm volatile("s_waitcnt vmcnt(" #N ")" : "+v"(Q.qv[0]), "+v"(Q.qv[1]), "+v"(Q.qv[2]), "+v"(Q.qv[3]), "+v"(Q.qv[4]), "+v"(Q.qv[5]), "+v"(Q.qv[6]), "+v"(Q.qv[7]), \
        "+v"(Q.ol[0]), "+v"(Q.ol[1]), "+v"(Q.ol[2]), "+v"(Q.ol[3]), "+v"(Q.egl) :: "memory");
#define SC_LOAD_QO(Q, n) { const int gc_ = SC_GC(n), pid_ = (gc_ * 4 + h) * 2 + d; \
        { const unsigned vo_ = (unsigned)(((w * 8) * 64 + lane) * 8); const void* sb_ = (const void*)(GQp + (size_t)pid_ * 16384); asm volatile("s_nop 4" ::: "memory"); \
          gl8s<0>(Q.qv[0], vo_, sb_); gl8s<512>(Q.qv[1], vo_, sb_); gl8s<1024>(Q.qv[2], vo_, sb_); gl8s<1536>(Q.qv[3], vo_, sb_); gl8s<2048>(Q.qv[4], vo_, sb_); gl8s<2560>(Q.qv[5], vo_, sb_); gl8s<3072>(Q.qv[6], vo_, sb_); gl8s<3584>(Q.qv[7], vo_, sb_); } \
        const bf16* op_ = OG + ((size_t)d * M + gc_ * 64 + c) * 512 + h * 128 + w * 16 + 4 * q; \
        _Pragma("unroll") for (int nt = 0; nt < 4; ++nt) gl8(Q.ol[nt], op_ + (size_t)nt * 16 * 512); gl4(Q.egl, GEGL + pid_); }
#define SC_STEP(n, Q) { const int gc_s = SC_GC(n); const LAS unsigned char* B = L + ((n) % 3) * 49152; \
        bf16x8 sb[4]; \
        _Pragma("unroll") for (int ks = 0; ks < 4; ++ks) { v4u p_; p_.x = pk2(acc[2 * ks][0], acc[2 * ks][1]); p_.y = pk2(acc[2 * ks][2], acc[2 * ks][3]); p_.z = pk2(acc[2 * ks + 1][0], acc[2 * ks + 1][1]); p_.w = pk2(acc[2 * ks + 1][2], acc[2 * ks + 1][3]); sb[ks] = __builtin_bit_cast(bf16x8, p_); } \
        SC_WAIT_QO(Q, 33) \
        f32x4 oacc[4]; \
        _Pragma("unroll") for (int nt = 0; nt < 4; ++nt) { oacc[nt][0] = bflo(Q.ol[nt].x); oacc[nt][1] = bfhi(Q.ol[nt].x); oacc[nt][2] = bflo(Q.ol[nt].y); oacc[nt][3] = bfhi(Q.ol[nt].y); } \
        _Pragma("unroll") for (int mt = 0; mt < 8; ++mt) { const float e_ = Q.egl; acc[mt][0] = e_ * acc[mt][0] + bflo(Q.qv[mt].x); acc[mt][1] = e_ * acc[mt][1] + bfhi(Q.qv[mt].x); acc[mt][2] = e_ * acc[mt][2] + bflo(Q.qv[mt].y); acc[mt][3] = e_ * acc[mt][3] + bfhi(Q.qv[mt].y); } \
        SC_LOAD_QO(Q, (n) + 2) \
        SC_DMA((n) + 2) \
        bf16* op_s = OG + ((size_t)d * M + gc_s * 64 + c) * 512 + h * 128 + w * 16 + 4 * q; \
        { v2u ost_[4]; \
          _Pragma("unroll") for (int hb = 0; hb < 2; ++hb) { bf16x8 f_[8]; \
            _Pragma("unroll") for (int i_ = 0; i_ < 8; ++i_) f_[i_] = *(const LAS bf16x8*)(B + 32768 + ((hb * 8 + i_) * 64 + lane) * 16); \
            __builtin_amdgcn_sched_barrier(0); \
            _Pragma("unroll") for (int n2 = 0; n2 < 2; ++n2) { const int nt = hb * 2 + n2; f32x4 o_ = oacc[nt]; \
                _Pragma("unroll") for (int ks = 0; ks < 4; ++ks) o_ = MFMA16(sb[ks], f_[n2 * 4 + ks], o_); \
                if (dry) o_ = oacc[nt]; ost_[nt].x = pk2(o_[0], o_[1]); ost_[nt].y = pk2(o_[2], o_[3]); } \
            __builtin_amdgcn_sched_barrier(0); } \
          _Pragma("unroll") for (int nt = 0; nt < 4; ++nt) *(v2u*)(op_s + (size_t)nt * 16 * 512) = ost_[nt]; } \
        _Pragma("unroll") for (int hb = 0; hb < 4; ++hb) { bf16x8 f_[8]; \
          _Pragma("unroll") for (int i_ = 0; i_ < 8; ++i_) f_[i_] = *(const LAS bf16x8*)(B + ((hb * 8 + i_) * 64 + lane) * 16); \
          __builtin_amdgcn_sched_barrier(0); \
          _Pragma("unroll") for (int m2 = 0; m2 < 2; ++m2) { f32x4 a_ = acc[hb * 2 + m2]; \
              _Pragma("unroll") for (int ks = 0; ks < 4; ++ks) a_ = MFMA16(f_[m2 * 4 + ks], sb[ks], a_); \
              acc[hb * 2 + m2] = a_; } \
          __builtin_amdgcn_sched_barrier(0); } \
        asm volatile("s_waitcnt vmcnt(27) lgkmcnt(0)" ::: "memory"); __builtin_amdgcn_s_barrier(); asm volatile("" ::: "memory"); }
    ScanQo q0, q1;
    SC_LOAD_QO(q0, 0) SC_LOAD_QO(q1, 1) SC_DMA(0) SC_DMA(1)
    SC_WAIT_QO(q0, 0) SC_WAIT_QO(q1, 0)
    asm volatile("s_waitcnt vmcnt(0) lgkmcnt(0)" ::: "memory"); __builtin_amdgcn_s_barrier(); asm volatile("" ::: "memory");
#pragma unroll 1
    for (int cc = 0; cc < nc; cc += 2) { SC_STEP(cc, q0) SC_STEP(cc + 1, q1) }
#undef SC_GC
#undef SC_DMA
#undef SC_WAIT_QO
#undef SC_LOAD_QO
#undef SC_STEP
    asm volatile("s_waitcnt vmcnt(0) lgkmcnt(0)" ::: "memory");
    if (!lat && !dry) { float* sp = C.outp() + O_SGDN + ((((size_t)seq * 2 + l) * 2 + d) * 4 + h) * 16384 + w * 16 + c;
#pragma unroll
        for (int mt = 0; mt < 8; ++mt)
#pragma unroll
            for (int r = 0; r < 4; ++r) sp[(size_t)(mt * 16 + 4 * q + r) * 128] = acc[mt][r]; }
    __syncthreads();
}
__device__ __forceinline__ int t32_off(int row, int col) { return row * 64 + (((col >> 3) ^ ((row >> 2) & 3)) << 4) + (col & 7) * 2; }
__device__ __forceinline__ bf16x8 frag32(const LAS unsigned char* T, int r0, int lane) { const int r = lane & 15, q = lane >> 4; return *(const LAS bf16x8*)(T + (r0 + r) * 64 + ((q ^ ((r >> 2) & 3)) << 4)); }
constexpr int GL_BC = 0, GL_TOT = 16384, GL_VT = 16896, GL_T0 = 25088;
__device__ __forceinline__ void gla_gates(Ctx& C, int l, const ChunkInfo& ci, int h, const bf16* PROJ) {
    LAS float* BC = (LAS float*)(C.lds + GL_BC); LAS float* TOT = (LAS float*)(C.lds + GL_TOT);
    int lane = C.lane; asm volatile("" : "+v"(lane)); const int w = C.wave, t = lane;
    const bf16* pr = PROJ + (size_t)(ci.row0 + t) * NINP;
#pragma unroll
    for (int d = 0; d < 2; ++d) { float lr[16]; load16bf(pr + (d ? C_GLRB : C_GLRF), lr);
        const float* up = C.inp(I_GKUP) + (size_t)(l * 2 + d) * 16 * 128 + h * 32 + w * 4; const float* bias = C.inp(I_GKB) + (l * 2 + d) * 128 + h * 32 + w * 4;
#pragma unroll
        for (int e = 0; e < 4; ++e) { float z = bias[e];
#pragma unroll
            for (int r = 0; r < 16; ++r) z += lr[r] * up[r * 128 + e];
            const float lg = (fminf(z, 0.f) - log1pf(__expf(-fabsf(z)))) * (1.0f / 16.0f);
            float ps = lg;
#pragma unroll
            for (int off = 1; off < 64; off <<= 1) { const float v = lane_read(ps, t >= off ? t - off : t); if (t >= off) ps += v; }
            const float tot = lane_read(ps, 63);
            BC[(d * 64 + t) * 32 + w * 4 + e] = d ? (tot - ps + lg) : ps;
            if (t == 0) TOT[d * 32 + w * 4 + e] = tot; } }
}
__device__ __forceinline__ void gla_load_vt(Ctx& C, const ChunkInfo& ci, int h, const bf16* PROJ) {
    const int t = C.tid >> 3, e8 = (C.tid & 7) * 8; float v[8];
    { const v4u a = *(const v4u*)(PROJ + (size_t)(ci.row0 + t) * NINP + C_GV + h * 64 + e8); v[0] = bflo(a.x); v[1] = bfhi(a.x); v[2] = bflo(a.y); v[3] = bfhi(a.y); v[4] = bflo(a.z); v[5] = bfhi(a.z); v[6] = bflo(a.w); v[7] = bfhi(a.w); }
#pragma unroll
    for (int i = 0; i < 8; ++i) *(LAS bf16*)(C.lds + GL_VT + t64_off(e8 + i, t)) = (bf16)f2bf(v[i]);
}
__device__ __forceinline__ void gla_prep_item(Ctx& C, int l, int gc, int h) {
    const ChunkInfo ci = chunk_info(gc); const bf16* PROJ = C.wsb(WS_PROJ);
    LAS float* BC = (LAS float*)(C.lds + GL_BC); LAS float* TOT = (LAS float*)(C.lds + GL_TOT);
    LAS unsigned char* KHT = C.lds + GL_T0;
    const v2u kv = *(const v2u*)(PROJ + (size_t)(ci.row0 + (C.tid >> 3)) * NINP + C_GK + h * 32 + (C.tid & 7) * 4);
    gla_gates(C, l, ci, h, PROJ); gla_load_vt(C, ci, h, PROJ);
    __syncthreads();
    { const int t = C.tid >> 3, dk4 = (C.tid & 7) * 4;
      const float k4[4] = {bflo(kv.x), bfhi(kv.x), bflo(kv.y), bfhi(kv.y)};
#pragma unroll
      for (int d = 0; d < 2; ++d)
#pragma unroll
          for (int e = 0; e < 4; ++e) *(LAS bf16*)(KHT + d * 4096 + t64_off(dk4 + e, t)) = (bf16)f2bf(k4[e] * __expf(TOT[d * 32 + dk4 + e] - BC[(d * 64 + t) * 32 + dk4 + e])); }
    __syncthreads();
    { int lane = C.lane; asm volatile("" : "+v"(lane)); const int q = lane >> 4, c = lane & 15, w = C.wave, d = w >> 2, mt = (w >> 1) & 1, nt0 = (w & 1) * 2;
      const int pid = (gc * 4 + h) * 2 + d; float* ds = C.wsf(WS_GLADS) + (size_t)pid * 2048;
      f32x4 acc[2] = {{0.f, 0.f, 0.f, 0.f}, {0.f, 0.f, 0.f, 0.f}};
#pragma unroll
      for (int ks = 0; ks < 2; ++ks) { const bf16x8 a = frag64(KHT + d * 4096, mt * 16, ks * 32, lane);
#pragma unroll
          for (int n = 0; n < 2; ++n) acc[n] = MFMA16(a, frag64(C.lds + GL_VT, (nt0 + n) * 16, ks * 32, lane), acc[n]); }
#pragma unroll
      for (int n = 0; n < 2; ++n)
#pragma unroll
          for (int r = 0; r < 4; ++r) ds[(mt * 16 + 4 * q + r) * 64 + (nt0 + n) * 16 + c] = acc[n][r];
      if (C.tid < 64) { const int dd = C.tid >> 5, dk = C.tid & 31; C.wsf(WS_GLADV)[((gc * 4 + h) * 2 + dd) * 32 + dk] = __expf(TOT[dd * 32 + dk]); } }
    __syncthreads();
}
struct S5Par { double lbr, lbi; float bre[16], bim[16]; };
__device__ __forceinline__ void s5_setup(Ctx& C, int l, int d, int g, int p, S5Par& P) {
    const int gi = (l * 2 + d) * 16 + g;
    const double lre = (double)C.inp(I_LRE)[gi * 64 + p], lim = (double)C.inp(I_LIM)[gi * 64 + p];
    const double step = (double)expf(C.inp(I_LSTEP)[gi]);
    const double a = lre * step, ang = lim * step;
    double ea = 1.0, term = 1.0;
#pragma unroll
    for (int n = 1; n <= 14; ++n) { term *= a / (double)n; ea += term; }
    const double TWO_PI = 6.283185307179586476925286766559;
    const double kk = rint(ang / TWO_PI); const double r = (ang - kk * TWO_PI) * 0.125, r2 = r * r;
    double sn = r * (1.0 + r2 * (-1.0 / 6 + r2 * (1.0 / 120 + r2 * (-1.0 / 5040 + r2 * (1.0 / 362880 + r2 * (-1.0 / 39916800 + r2 * (1.0 / 6227020800.0)))))));
    double cs = 1.0 + r2 * (-0.5 + r2 * (1.0 / 24 + r2 * (-1.0 / 720 + r2 * (1.0 / 40320 + r2 * (-1.0 / 3628800 + r2 * (1.0 / 479001600.0 + r2 * (-1.0 / 87178291200.0)))))));
#pragma unroll
    for (int n = 0; n < 3; ++n) { const double s2 = 2.0 * sn * cs, c2 = cs * cs - sn * sn; sn = s2; cs = c2; }
    P.lbr = ea * cs; P.lbi = ea * sn;
    const double nr = P.lbr - 1.0, ni = P.lbi, den = lre * lre + lim * lim;
    const float cfr = (float)((nr * lre + ni * lim) / den), cfi = (float)((ni * lre - nr * lim) / den);
    const float* br = C.inp(I_BRE) + ((size_t)gi * 64 + p) * 16; const float* bi = C.inp(I_BIM) + ((size_t)gi * 64 + p) * 16;
#pragma unroll
    for (int ch = 0; ch < 16; ++ch) { P.bre[ch] = cfr * br[ch] - cfi * bi[ch]; P.bim[ch] = cfr * bi[ch] + cfi * br[ch]; }
}
constexpr int S5_BB = 0, S5_CB = 8192, S5_BUT = 12288, S5_HT = S5_BUT + 8 * 8448;
__device__ __forceinline__ void s5_write_bb(const S5Par& P, LAS unsigned char* BB, int p) {
    v4u z = {0u, 0u, 0u, 0u}; v4u r0, r1, i0, i1;
    r0.x = pk2(P.bre[0], P.bre[1]); r0.y = pk2(P.bre[2], P.bre[3]); r0.z = pk2(P.bre[4], P.bre[5]); r0.w = pk2(P.bre[6], P.bre[7]);
    r1.x = pk2(P.bre[8], P.bre[9]); r1.y = pk2(P.bre[10], P.bre[11]); r1.z = pk2(P.bre[12], P.bre[13]); r1.w = pk2(P.bre[14], P.bre[15]);
    i0.x = pk2(P.bim[0], P.bim[1]); i0.y = pk2(P.bim[2], P.bim[3]); i0.z = pk2(P.bim[4], P.bim[5]); i0.w = pk2(P.bim[6], P.bim[7]);
    i1.x = pk2(P.bim[8], P.bim[9]); i1.y = pk2(P.bim[10], P.bim[11]); i1.z = pk2(P.bim[12], P.bim[13]); i1.w = pk2(P.bim[14], P.bim[15]);
    LAS v4u* rr = (LAS v4u*)(BB + p * 64); rr[0] = r0; rr[1] = r1; rr[2] = z; rr[3] = z;
    LAS v4u* ri = (LAS v4u*)(BB + (64 + p) * 64); ri[0] = i0; ri[1] = i1; ri[2] = z; ri[3] = z;
}
__device__ __forceinline__ bf16x8 s5_load_uf(const bf16* PROJ, int gc, int g, int tb, int lane) {
    const int q = lane >> 4, c = lane & 15; bf16x8 uf = {0, 0, 0, 0, 0, 0, 0, 0};
    if (q < 2) uf = *(const bf16x8*)(PROJ + (size_t)(gc * 64 + tb + c) * NINP + C_SU + g * 16 + 8 * q);
    return uf;
}
__device__ __forceinline__ void s5_bu_quarter(bf16x8 uf, const LAS unsigned char* BB, LAS float* BUT, int lane) {
    const int q = lane >> 4, c = lane & 15;
    bf16x8 bf[8];
#pragma unroll
    for (int nt = 0; nt < 8; ++nt) bf[nt] = *(const LAS bf16x8*)(BB + (nt * 16 + c) * 64 + q * 16);
#pragma unroll
    for (int nt = 0; nt < 8; ++nt) { f32x4 acc = {0.f, 0.f, 0.f, 0.f}; acc = MFMA16(bf[nt], uf, acc);
        *(LAS f32x4*)(BUT + c * 132 + nt * 16 + 4 * q) = acc; }
    asm volatile("s_waitcnt lgkmcnt(0)" ::: "memory");
}
__device__ __forceinline__ void s5_prep_blk(Ctx& C, int l, int bi) {
    const int gd = bi & 31, g = gd >> 1, d = gd & 1, cg = bi >> 5, p = C.lane;
    LAS unsigned char* BB = C.lds + S5_BB; LAS float* BUT = (LAS float*)(C.lds + S5_BUT + C.wave * 8448);
    const bf16* PROJ = C.wsb(WS_PROJ); float* S5E = C.wsf(WS_S5E);
    S5Par P; s5_setup(C, l, d, g, p, P);
    if (C.wave == 0) s5_write_bb(P, BB, p);
    __syncthreads();
    const float lbr = (float)P.lbr, lbi = (float)P.lbi;
    bf16x8 ufr[2][4];
#pragma unroll
    for (int j = 0; j < 2; ++j)
#pragma unroll
        for (int qq = 0; qq < 4; ++qq) ufr[j][qq] = s5_load_uf(PROJ, cg * 16 + C.wave * 2 + j, g, d ? 48 - 16 * qq : 16 * qq, p);
#pragma unroll
    for (int j = 0; j < 2; ++j) { const int gc = cg * 16 + C.wave * 2 + j; const size_t item = (size_t)(gc * 16 + g) * 2 + d;
        float hr = 0.f, hi = 0.f;
#pragma unroll
        for (int qq = 0; qq < 4; ++qq) { const int tb = d ? 48 - 16 * qq : 16 * qq;
            s5_bu_quarter(ufr[j][qq], BB, BUT, p);
#pragma unroll
            for (int ii = 0; ii < 16; ++ii) { const int tl = d ? 15 - ii : ii; const float br = BUT[tl * 132 + p], bi2 = BUT[tl * 132 + 64 + p];
                const float nr = lbr * hr - lbi * hi + br, ni = lbr * hi + lbi * hr + bi2; hr = nr; hi = ni; }
            asm volatile("s_waitcnt lgkmcnt(0)" ::: "memory"); }
        S5E[item * 128 + p] = hr; S5E[item * 128 + 64 + p] = hi; }
    __syncthreads();
}
__device__ __forceinline__ void ph_prep(Ctx& C, int l) {
    for (int it = C.vb; it < 256; it += C.nb) gdn_prep_item(C, l, 64 + (it >> 2), it & 3);
    for (int it = C.vb; it < 512; it += C.nb) gla_prep_item(C, l, it >> 2, it & 3);
    for (int bi = C.vb; bi < 256; bi += C.nb) s5_prep_blk(C, l, bi);
}

__device__ __forceinline__ void gla_scan_unit(Ctx& C, int l, int seq, int h, int d) {
    const int tid = C.tid; const int lat = seq >= 16, nc = lat ? 32 : 4, gc0 = lat ? 64 + (seq - 16) * 32 : seq * 4;
    const int dk = tid >> 4, e0 = (tid & 15) * 4;
    float* GLASC = C.wsf(WS_GLASC); const float* GLADS = C.wsf(WS_GLADS); const float* GLADV = C.wsf(WS_GLADV);
    f32x4 s = {0.f, 0.f, 0.f, 0.f};
    if (lat) s = *(const f32x4*)(C.inp(I_SGLA) + (((((size_t)(seq - 16) * 2 + l) * 2 + d) * 4 + h) * 32 + dk) * 64 + e0);
    for (int c0 = 0; c0 < nc; c0 += 4) {
        float dv[4]; f32x4 ds[4];
#pragma unroll
        for (int k = 0; k < 4; ++k) { const int cc = c0 + k, gc = gc0 + (d ? nc - 1 - cc : cc), pid = (gc * 4 + h) * 2 + d; dv[k] = GLADV[pid * 32 + dk]; ds[k] = *(const f32x4*)(GLADS + (size_t)pid * 2048 + dk * 64 + e0); }
#pragma unroll
        for (int k = 0; k < 4; ++k) { const int cc = c0 + k, gc = gc0 + (d ? nc - 1 - cc : cc), pid = (gc * 4 + h) * 2 + d;
            *(f32x4*)(GLASC + (size_t)pid * 2048 + dk * 64 + e0) = s; s = s * dv[k] + ds[k]; } }
    if (!lat) *(f32x4*)(C.outp() + O_SGLA + (((((size_t)seq * 2 + l) * 2 + d) * 4 + h) * 32 + dk) * 64 + e0) = s;
}
__device__ __forceinline__ void s5_scan_unit(Ctx& C, int l, int unit) {
    const int d = unit & 1, g = (unit >> 1) & 15, seq = unit >> 5, p = C.lane;
    const int lat = seq >= 16, nc = lat ? 32 : 4, gc0 = lat ? 64 + (seq - 16) * 32 : seq * 4;
    const float* S5E = C.wsf(WS_S5E); float* S5HS = C.wsf(WS_S5HS);
    S5Par P; s5_setup(C, l, d, g, p, P);
    double pr = P.lbr, pi = P.lbi;
#pragma unroll
    for (int n = 0; n < 6; ++n) { const double r2 = pr * pr - pi * pi, i2 = 2.0 * pr * pi; pr = r2; pi = i2; }
    const float l64r = (float)pr, l64i = (float)pi;
    float hr = 0.f, hi = 0.f;
    if (lat) { const size_t o = ((((size_t)(seq - 16) * 2 + l) * 2 + d) * 16 + g) * 64 + p; hr = C.inp(I_S5RE)[o]; hi = C.inp(I_S5IM)[o]; }
    for (int c0 = 0; c0 < nc; c0 += 4) {
        float er[4], ei[4];
#pragma unroll
        for (int k = 0; k < 4; ++k) { const int cc = c0 + k, gc = gc0 + (d ? nc - 1 - cc : cc); const size_t item = (size_t)(gc * 16 + g) * 2 + d; er[k] = S5E[item * 128 + p]; ei[k] = S5E[item * 128 + 64 + p]; }
#pragma unroll
        for (int k = 0; k < 4; ++k) { const int cc = c0 + k, gc = gc0 + (d ? nc - 1 - cc : cc); const size_t item = (size_t)(gc * 16 + g) * 2 + d;
            S5HS[item * 128 + p] = hr; S5HS[item * 128 + 64 + p] = hi;
            const float nr = l64r * hr - l64i * hi + er[k], ni = l64r * hi + l64i * hr + ei[k]; hr = nr; hi = ni; } }
    if (!lat) { const size_t o = ((((size_t)seq * 2 + l) * 2 + d) * 16 + g) * 64 + p; C.outp()[O_S5RE + o] = hr; C.outp()[O_S5IM + o] = hi; }
}
__device__ __forceinline__ void gla_out_item(Ctx& C, int l, int gc, int h) {
    const ChunkInfo ci = chunk_info(gc); const bf16* PROJ = C.wsb(WS_PROJ);
    LAS float* BC = (LAS float*)(C.lds + GL_BC);
    LAS unsigned char* QT = C.lds + GL_T0;
    LAS unsigned char* KT = QT + 8192;
    LAS unsigned char* SCT = KT + 8192;
    LAS unsigned char* AM = SCT + 8192;
    v2u qv, kv; f32x4 scv[2];
    { const int t = C.tid >> 3, dk4 = (C.tid & 7) * 4; const bf16* pr = PROJ + (size_t)(ci.row0 + t) * NINP;
      qv = *(const v2u*)(pr + C_GQ + h * 32 + dk4); kv = *(const v2u*)(pr + C_GK + h * 32 + dk4);
      const int dk = C.tid >> 4, e4 = (C.tid & 15) * 4;
#pragma unroll
      for (int d = 0; d < 2; ++d) scv[d] = *(const f32x4*)(C.wsf(WS_GLASC) + (size_t)((gc * 4 + h) * 2 + d) * 2048 + dk * 64 + e4); }
    gla_gates(C, l, ci, h, PROJ); gla_load_vt(C, ci, h, PROJ);
    __syncthreads();
    { const int t = C.tid >> 3, dk4 = (C.tid & 7) * 4;
      const float q4[4] = {bflo(qv.x), bfhi(qv.x), bflo(qv.y), bfhi(qv.y)}, k4[4] = {bflo(kv.x), bfhi(kv.x), bflo(kv.y), bfhi(kv.y)};
#pragma unroll
      for (int d = 0; d < 2; ++d) { float eb[4];
#pragma unroll
          for (int e = 0; e < 4; ++e) eb[e] = BC[(d * 64 + t) * 32 + dk4 + e];
          v2u qo, ko; qo.x = pk2(q4[0] * 0.17677669529663687f * __expf(eb[0]), q4[1] * 0.17677669529663687f * __expf(eb[1])); qo.y = pk2(q4[2] * 0.17677669529663687f * __expf(eb[2]), q4[3] * 0.17677669529663687f * __expf(eb[3]));
          ko.x = pk2(k4[0] * __expf(-eb[0]), k4[1] * __expf(-eb[1])); ko.y = pk2(k4[2] * __expf(-eb[2]), k4[3] * __expf(-eb[3]));
          *(LAS v2u*)(QT + d * 4096 + t32_off(t, dk4)) = qo; *(LAS v2u*)(KT + d * 4096 + t32_off(t, dk4)) = ko; }
      const int dk = C.tid >> 4, e4 = (C.tid & 15) * 4;
#pragma unroll
      for (int d = 0; d < 2; ++d) { const f32x4 sv = scv[d];
          *(LAS bf16*)(SCT + d * 4096 + t32_off(e4, dk)) = (bf16)f2bf(sv.x); *(LAS bf16*)(SCT + d * 4096 + t32_off(e4 + 1, dk)) = (bf16)f2bf(sv.y);
          *(LAS bf16*)(SCT + d * 4096 + t32_off(e4 + 2, dk)) = (bf16)f2bf(sv.z); *(LAS bf16*)(SCT + d * 4096 + t32_off(e4 + 3, dk)) = (bf16)f2bf(sv.w); } }
    __syncthreads();
    { int lane = C.lane; asm volatile("" : "+v"(lane)); const int q = lane >> 4, c = lane & 15, w = C.wave, d = w >> 2, mt = w & 3;
      const bf16x8 a = frag32(QT + d * 4096, mt * 16, lane);
#pragma unroll
      for (int nt = 0; nt < 4; ++nt) { f32x4 acc = {0.f, 0.f, 0.f, 0.f}; acc = MFMA16(a, frag32(KT + d * 4096, nt * 16, lane), acc);
#pragma unroll
          for (int r = 0; r < 4; ++r) { const int t = mt * 16 + 4 * q + r, s_ = nt * 16 + c; const bool keep = d ? (s_ >= t) : (s_ <= t);
              *(LAS bf16*)(AM + d * 8192 + t64_off(t, s_)) = (bf16)f2bf(keep ? acc[r] : 0.f); } } }
    __syncthreads();
    { int lane = C.lane; asm volatile("" : "+v"(lane)); const int q = lane >> 4, c = lane & 15, w = C.wave, d = w >> 2, ntk = w & 3;
      float* og = C.wsf(WS_OGLA) + ((size_t)d * M + ci.row0 + ntk * 16 + c) * 256 + h * 64 + 4 * q;
      const bf16x8 bq = frag32(QT + d * 4096, ntk * 16, lane), b0 = frag64(AM + d * 8192, ntk * 16, 0, lane), b1 = frag64(AM + d * 8192, ntk * 16, 32, lane);
#pragma unroll
      for (int me = 0; me < 4; ++me) { f32x4 acc = {0.f, 0.f, 0.f, 0.f};
          acc = MFMA16(frag64(C.lds + GL_VT, me * 16, 0, lane), b0, acc); acc = MFMA16(frag64(C.lds + GL_VT, me * 16, 32, lane), b1, acc);
          acc = MFMA16(frag32(SCT + d * 4096, me * 16, lane), bq, acc);
          *(f32x4*)(og + me * 16) = acc; } }
    __syncthreads();
}
__device__ __forceinline__ int t256_off(int row, int col) { return row * 512 + (((col >> 3) ^ (row & 15)) << 4) + (col & 7) * 2; }
__device__ __forceinline__ void s5_out_blk(Ctx& C, int l, int bi) {
    const int gd = bi & 31, g = gd >> 1, d = gd & 1, cg = bi >> 5, p = C.lane, q = p >> 4, c = p & 15;
    LAS unsigned char* BB = C.lds + S5_BB; LAS unsigned char* CB = C.lds + S5_CB;
    LAS float* BUT = (LAS float*)(C.lds + S5_BUT + C.wave * 8448); LAS unsigned char* HT = C.lds + S5_HT + C.wave * 4096;
    const bf16* PROJ = C.wsb(WS_PROJ); const float* S5HS = C.wsf(WS_S5HS); float* YS5 = C.wsf(WS_YS5);
    const int gi = (l * 2 + d) * 16 + g;
    { const float* cre = C.inp(I_CRE) + (size_t)gi * 1024; const float* cim = C.inp(I_CIM) + (size_t)gi * 1024;
#pragma unroll
      for (int k = 0; k < 4; ++k) { const int idx = C.tid + k * NTHR, ch = idx >> 7, kk = idx & 127;
          *(LAS bf16*)(CB + t128_off(ch, kk)) = (bf16)f2bf(kk < 64 ? cre[ch * 64 + kk] : -cim[ch * 64 + kk - 64]); } }
    S5Par P; s5_setup(C, l, d, g, p, P);
    if (C.wave == 0) s5_write_bb(P, BB, p);
    __syncthreads();
    const float lbr = (float)P.lbr, lbi = (float)P.lbi;
    bf16x8 ufr[2][4]; float hs[2][2];
#pragma unroll
    for (int j = 0; j < 2; ++j) { const size_t item = (size_t)((cg * 16 + C.wave * 2 + j) * 16 + g) * 2 + d; hs[j][0] = S5HS[item * 128 + p]; hs[j][1] = S5HS[item * 128 + 64 + p];
#pragma unroll
        for (int qq = 0; qq < 4; ++qq) ufr[j][qq] = s5_load_uf(PROJ, cg * 16 + C.wave * 2 + j, g, d ? 48 - 16 * qq : 16 * qq, p); }
#pragma unroll
    for (int j = 0; j < 2; ++j) { const int gc = cg * 16 + C.wave * 2 + j;
        float hr = hs[j][0], hi = hs[j][1];
#pragma unroll
        for (int qq = 0; qq < 4; ++qq) { const int tb = d ? 48 - 16 * qq : 16 * qq;
            s5_bu_quarter(ufr[j][qq], BB, BUT, p);
#pragma unroll
            for (int ii = 0; ii < 16; ++ii) { const int tl = d ? 15 - ii : ii; const float br = BUT[tl * 132 + p], bi2 = BUT[tl * 132 + 64 + p];
                const float nr = lbr * hr - lbi * hi + br, ni = lbr * hi + lbi * hr + bi2; hr = nr; hi = ni;
                *(LAS bf16*)(HT + t128_off(tl, p)) = (bf16)f2bf(hr); *(LAS bf16*)(HT + t128_off(tl, 64 + p)) = (bf16)f2bf(hi); }
            asm volatile("s_waitcnt lgkmcnt(0)" ::: "memory");
            f32x4 acc = {0.f, 0.f, 0.f, 0.f};
#pragma unroll
            for (int ks = 0; ks < 4; ++ks) acc = MFMA16(frag128(HT, 0, ks * 32, p), frag128(CB, 0, ks * 32, p), acc);
#pragma unroll
            for (int r = 0; r < 4; ++r) YS5[((size_t)d * M + gc * 64 + tb + 4 * q + r) * 256 + g * 16 + c] = acc[r];
            asm volatile("s_waitcnt lgkmcnt(0)" ::: "memory"); } }
    __syncthreads();
}

__device__ __forceinline__ void sub_barrier(Ctx& C, unsigned* cnt, unsigned target) {
    asm volatile("s_waitcnt vmcnt(0)" ::: "memory");
    __syncthreads();
    if (C.tid == 0) {
        __builtin_amdgcn_fence(__ATOMIC_RELEASE, "agent"); asm volatile("s_waitcnt vmcnt(0)" ::: "memory");
        __hip_atomic_fetch_add(cnt, 1u, __ATOMIC_RELAXED, __HIP_MEMORY_SCOPE_AGENT);
        unsigned spins = 0;
        while (__hip_atomic_load(cnt, __ATOMIC_RELAXED, __HIP_MEMORY_SCOPE_AGENT) < target) { __builtin_amdgcn_s_sleep(4); if (++spins > (1u << 22)) break; }
        __builtin_amdgcn_fence(__ATOMIC_ACQUIRE, "agent"); asm volatile("s_waitcnt vmcnt(0)" ::: "memory");
    }
    __syncthreads();
}
__device__ __forceinline__ int wq_next(Ctx& C, unsigned* q) {
    volatile LAS int* slot = (volatile LAS int*)(C.lds + LDS_CTL_OFF + 64);
    __syncthreads();
    if (C.tid == 0) *slot = (int)__hip_atomic_fetch_add(q, 1u, __ATOMIC_RELAXED, __HIP_MEMORY_SCOPE_AGENT);
    __syncthreads();
    return *slot;
}
__device__ __forceinline__ void ph_scan(Ctx& C, int l, int mode) {
    if (C.nb < 64) return;
    const int NS = C.nb - 16;
    if (C.vb < 16) { gdn_scan_unit(C, l, 16 + (C.vb >> 3), (C.vb >> 1) & 3, C.vb & 1, false); return; }
    unsigned* ctl = (unsigned*)(C.ws + WS_SUBBAR) + l * 256;
#define WQ_CTX() Ctx Ci = C; { int t_ = C.tid; asm volatile("" : "+v"(t_)); Ci.tid = t_; Ci.lane = t_ & 63; }
#pragma unroll 1
    for (int it = wq_next(C, ctl + 64); it < 472; it = wq_next(C, ctl + 64)) { WQ_CTX();
        if (it < 256) gdn_prep_item(Ci, l, it >> 2, it & 3);
        else if (it < 400) { const int u = it - 256; gla_scan_unit(Ci, l, u >> 3, (u >> 1) & 3, u & 1); }
        else s5_scan_unit(Ci, l, (it - 400) * NWAVES + Ci.wave); }
    sub_barrier(C, ctl, (unsigned)NS);
#pragma unroll 1
    for (int it = wq_next(C, ctl + 128); it < 896; it = wq_next(C, ctl + 128)) { WQ_CTX();
        if (it < 128) { const int u = 16 + it; gdn_scan_unit(Ci, l, (u - 16) >> 3, (u >> 1) & 3, u & 1, false); }
        else if (it < 384) s5_out_blk(Ci, l, it - 128);
        else { const int g = it - 384; gla_out_item(Ci, l, g >> 2, g & 3); } }
#undef WQ_CTX
}

__device__ __forceinline__ void ph_post(Ctx& C, int l) {
    LAS unsigned char* Gb = C.lds;
    const int tid = C.tid, lane = C.lane, wave = C.wave;
    const bf16* PROJ = C.wsb(WS_PROJ); const float* YS5 = C.wsf(WS_YS5); const bf16* WGT = C.wsb(WS_WGLU); bf16* HNp = C.wsb(WS_HN); const bf16* OGD = C.wsb(WS_OGDN);
    const float* glanw = C.inp(I_GLANW); const float* gdnnw = C.inp(I_GDNNW); const float* s5d = C.inp(I_S5D); const float* wglu = C.inp(I_WGLU); const float* bglu = C.inp(I_BGLU);
    for (int tile = C.vb; tile < 256; tile += C.nb) {
        const int r0 = tile * 32;
        for (int pr = wave; pr < 128; pr += NWAVES) { const int row = r0 + (pr >> 2), h = pr & 3;
            const float o = C.wsf(WS_OGLA)[(size_t)row * 256 + h * 64 + lane] + C.wsf(WS_OGLA)[((size_t)M + row) * 256 + h * 64 + lane];
            const float rs = 1.0f / sqrtf(wave_sum(o * o) * (1.f / 64.f) + 1e-6f);
            const float gate = bf2f(C.wsb(WS_PROJ)[(size_t)row * NINP + C_GOG + h * 64 + lane]);
            C.wsb(WS_HN)[(size_t)row * D + h * 64 + lane] = (bf16)f2bf(o * rs * glanw[l * 64 + lane] * siluf(gate)); }
        for (int pr = wave; pr < 128; pr += NWAVES) { const int row = r0 + (pr >> 2), h = pr & 3;
            const unsigned a0 = *(const unsigned*)(OGD + (size_t)row * 512 + h * 128 + 2 * lane), a1 = *(const unsigned*)(OGD + ((size_t)M + row) * 512 + h * 128 + 2 * lane);
            const float o0 = bflo(a0) + bflo(a1), o1 = bfhi(a0) + bfhi(a1);
            const float rs = 1.0f / sqrtf(wave_sum(o0 * o0 + o1 * o1) * (1.f / 128.f) + 1e-6f);
            const unsigned gg = *(const unsigned*)(PROJ + (size_t)row * NINP + C_DOG + h * 128 + 2 * lane);
            *(unsigned*)(HNp + (size_t)row * D + 256 + h * 128 + 2 * lane) = pk2(o0 * rs * gdnnw[l * 128 + 2 * lane] * siluf(bflo(gg)), o1 * rs * gdnnw[l * 128 + 2 * lane + 1] * siluf(bfhi(gg))); }
        for (int idx = tid; idx < 32 * 256; idx += NTHR) { const int tk = idx >> 8, row = r0 + tk, cix = idx & 255;
            const float y = bf2f(PROJ[(size_t)row * NINP + C_SU + cix]) * s5d[l * 256 + cix] + YS5[(size_t)row * 256 + cix] + YS5[((size_t)M + row) * 256 + cix];
            const float in = 0.7978845608028654f * (y + 0.044715f * y * y * y);
            *(LAS bf16*)(Gb + t256_off(tk, cix)) = (bf16)f2bf(0.5f * y * (2.0f - 2.0f / (1.0f + __expf(2.0f * in)))); }
        __syncthreads();
        { const int q = lane >> 4, c = lane & 15;
          f32x4 acc[2][2];
#pragma unroll
          for (int a = 0; a < 2; ++a)
#pragma unroll
              for (int m = 0; m < 2; ++m) acc[a][m] = (f32x4){0.f, 0.f, 0.f, 0.f};
          const bf16* wt = WGT + (size_t)(wave * 32 + c) * 256 + 8 * q;
#pragma unroll
          for (int ks = 0; ks < 8; ++ks) { const bf16x8 a0 = *(const bf16x8*)(wt + ks * 32), a1 = *(const bf16x8*)(wt + 16 * 256 + ks * 32);
              const bf16x8 b0 = *(const LAS bf16x8*)(Gb + c * 512 + (((4 * ks + q) ^ c) << 4)), b1 = *(const LAS bf16x8*)(Gb + (16 + c) * 512 + (((4 * ks + q) ^ c) << 4));
              acc[0][0] = MFMA16(a0, b0, acc[0][0]); acc[0][1] = MFMA16(a0, b1, acc[0][1]); acc[1][0] = MFMA16(a1, b0, acc[1][0]); acc[1][1] = MFMA16(a1, b1, acc[1][1]); }
#pragma unroll
          for (int a = 0; a < 2; ++a)
#pragma unroll
              for (int m = 0; m < 2; ++m) { const int n0 = wave * 32 + a * 16 + 4 * q, tk = m * 16 + c;
                  const v2u gv = *(const LAS v2u*)(Gb + t256_off(tk, n0)); const f32x4 bg = *(const f32x4*)(bglu + l * 256 + n0);
                  v2u o; o.x = pk2(bflo(gv.x) * sigmf(acc[a][m][0] + bg.x), bfhi(gv.x) * sigmf(acc[a][m][1] + bg.y)); o.y = pk2(bflo(gv.y) * sigmf(acc[a][m][2] + bg.z), bfhi(gv.y) * sigmf(acc[a][m][3] + bg.w));
                  *(v2u*)(HNp + (size_t)(r0 + tk) * D + 768 + n0) = o; } }
        __syncthreads();
    }
}
constexpr int REP_KIND = -1, REP_N = 1;
#ifndef PHASE_MASK
#define PHASE_MASK 0xffffffffu
#endif
constexpr int PH_PER_LAYER = 11, N_PHASES = 1 + 2 * PH_PER_LAYER + 1;
#define MKCTX() Ctx C; { int tid_ = threadIdx.x; asm volatile("" : "+v"(tid_)); int vbr_ = blockIdx.x; asm volatile("" : "+s"(vbr_)); \
    C.lds = (LAS unsigned char*)lds_raw; C.tid = tid_; C.lane = tid_ & 63; C.wave = __builtin_amdgcn_readfirstlane(tid_ >> 6); \
    C.nb = gridDim.x; C.vb_raw = vbr_; C.vb = (C.nb % 8 == 0) ? (vbr_ % 8) * (C.nb / 8) + vbr_ / 8 : vbr_; \
    C.out = (float*)(GAS float*)C.ptab(34); C.ws = (unsigned char*)(GAS unsigned char*)C.ptab(35); }
#define IN(k) (lo <= (k) && (k) < hi)
#define SEAM(k) do { if ((k) + 1 < hi) xcd_barrier(bar); } while (0)
__device__ __forceinline__ float* ss_ptr(Ctx& C, int l, int inst) { return (float*)(C.ws + WS_SS) + (size_t)(l * 3 + inst) * M; }
template <int KIND>
__device__ __forceinline__ void gemm_res(Ctx& C, int l) {
    constexpr int j = KIND == 13; constexpr int KF = KIND == 10 ? D : FF; const bool first = (l == 0 && KIND == 3);
    const float* xb0 = C.outp(); const float* xb1 = xb0 + (size_t)MCTX * D;
    pg8::Gemm g{KIND == 10 ? C.wsb(WS_HN) : C.wsb(WS_H), KIND == 10 ? C.wsb(WS_WOUT) : C.wsb(WS_WD) + (size_t)j * D * FF, M, D, KF, KF}; pg8::StaticOrder S; S.init(M, D, C.nb, C.vb_raw, 1, 128);
    constexpr int gi = KIND == 3 ? 2 : (KIND == 10 ? 5 : 8);
    const int nl = KIND == 13 ? l + 1 : l, ninst = KIND == 3 ? 1 : (KIND == 10 ? 2 : 0); const bool has_next = nl < 2;
    pg8::EpiRes<true> E{first ? C.inp(I_XP) : xb0, first ? C.inp(I_XS) : xb1, C.outp(), KIND == 10 ? C.wsb(WS_HN2) : C.wsb(WS_HN), has_next ? ss_ptr(C, nl, ninst) : nullptr,
                  has_next ? C.wsf(WS_CW) + (size_t)(nl * 3 + ninst) * 3 * D : nullptr, C.wsf(WS_MOD) + (size_t)l * 3 * 9216 + gi * D, KIND == 10 ? 1.0f : 0.5f};
    pg8::gemm_phase<pg8::EpiRes<true>, pg8::StaticOrder, true, true, true>(C.lds, g, S, E, C.tid);
}
template <class Sched>
__device__ __forceinline__ const LAS float* fill_epi_lds(Ctx& C, const Sched& S, const float* SS, const float* bias, int ncols) {
    LAS float* EP = (LAS float*)(C.lds + 131072);
    for (int i = 0; i < 8; ++i) { pg8::Unit u; if (!S.next(i, u)) break;
        const int cid = u.pm < 16 ? 0 : 1 + ((u.pm - 16) >> 3), t = C.tid;
        EP[i * 512 + t] = t < 256 ? 1.0f / sqrtf(SS[u.pm * 256 + t] * (1.f / D) + 1e-6f) : bias[(size_t)cid * ncols + u.pn * 256 + (t - 256)]; }
    __syncthreads();
    return EP;
}
__device__ __forceinline__ void gemm_gu(Ctx& C, int l, int j) {
    pg8::Gemm g{j ? C.wsb(WS_HN2) : C.wsb(WS_HN), C.wsb(WS_WGU) + (size_t)j * NGU * D, M, NGU, D, D}; pg8::StaticOrder S; S.init(M, NGU, C.nb, C.vb_raw);
    pg8::EpiGU E{C.wsb(WS_H), fill_epi_lds(C, S, ss_ptr(C, l, j ? 2 : 0), C.wsf(WS_BGU) + (size_t)j * 3 * NGU, NGU)};
    pg8::gemm_phase<pg8::EpiGU, pg8::StaticOrder, true, true>(C.lds, g, S, E, C.tid);
}
__device__ __forceinline__ void gemm_inproj(Ctx& C, int l) {
    pg8::Gemm g{C.wsb(WS_HN), C.wsb(WS_WIN), M, NINP, D, D}; pg8::StaticOrder S; S.init(M, NINP, C.nb, C.vb_raw);
    pg8::EpiProj E{C.wsb(WS_PROJ), NINP, fill_epi_lds(C, S, ss_ptr(C, l, 1), C.wsf(WS_BIN), NINP)};
    pg8::gemm_phase<pg8::EpiProj, pg8::StaticOrder, true, true>(C.lds, g, S, E, C.tid);
}
__global__ void __launch_bounds__(NTHR, 2) fwd_kernel(Args a) {
    extern __shared__ __attribute__((aligned(16))) unsigned char lds_raw[];
    volatile LAS unsigned* MISC = (volatile LAS unsigned*)((LAS unsigned char*)lds_raw + LDS_CTL_OFF);
    if (threadIdx.x < 64) MISC[threadIdx.x] = 0u;
    if (threadIdx.x < 36) { const unsigned long long v = threadIdx.x < 34 ? (unsigned long long)a.in[threadIdx.x] : (threadIdx.x == 34 ? (unsigned long long)a.out : (unsigned long long)a.ws);
        MISC[64 + 2 * threadIdx.x] = (unsigned)v; MISC[64 + 2 * threadIdx.x + 1] = (unsigned)(v >> 32); }
    __syncthreads();
    XcdBarrier bar = xcd_barrier_post((unsigned*)(a.ws + WS_CTL) + CW_BAR, MISC + 8);
    const int lo = a.ph_lo, hi = a.ph_hi;
#define PHASE(k, kind, body) if (((PHASE_MASK >> ((kind) & 31)) & 1u) && IN(k)) { const int nrep_ = ((kind) == REP_KIND) ? REP_N : 1; _Pragma("unroll 1") for (int rep = 0; rep < nrep_; ++rep) { MKCTX(); body; } SEAM(k); }
    PHASE(0, 20, ph_mod(C); __syncthreads(); ph_wconv(C, 0))
#define LAYER(l) { constexpr int b = 1 + (l) * PH_PER_LAYER; \
        if ((l) > 0) { PHASE(b + 0, 0, ph_wconv(C, l)) } \
        PHASE(b + 1, 1, ph_bias(C, l); if ((l) == 0) ph_xb0(C)) \
        PHASE(b + 2, 2, gemm_gu(C, l, 0)) \
        PHASE(b + 3, 3, gemm_res<3>(C, l)) \
        PHASE(b + 4, 5, gemm_inproj(C, l)) \
        PHASE(b + 5, 6, ph_prep(C, l)) \
        PHASE(b + 6, 7, ph_scan(C, l, 0)) \
        PHASE(b + 7, 9, ph_post(C, l)) \
        PHASE(b + 8, 10, gemm_res<10>(C, l)) \
        PHASE(b + 9, 2, gemm_gu(C, l, 1)) \
        PHASE(b + 10, 3, gemm_res<13>(C, l)) }
    LAYER(0)
    LAYER(1)
    if (IN(N_PHASES - 1)) { MKCTX(); ph_final(C); if (REP_KIND == 100) for (int rep = 0; rep < REP_N; ++rep) xcd_barrier(bar); }
}

extern "C" void kernel_launch(void* const* d_in, const int* in_sizes, int n_in, void* d_out, int out_size, void* d_ws, size_t ws_size, hipStream_t stream) {
    static int grid = 0;
    if (grid == 0) {
        if (n_in != 34 || (size_t)out_size != O_END || ws_size < WS_END) { fprintf(stderr, "kernel_launch: unexpected shapes: n_in %d out %d ws %zu\n", n_in, out_size, ws_size); grid = -1; return; }
        int dev = 0, cus = 0, per_cu = 0;
        if (hipGetDevice(&dev) != hipSuccess || hipDeviceGetAttribute(&cus, hipDeviceAttributeMultiprocessorCount, dev) != hipSuccess) { grid = -1; return; }
        if (hipFuncSetAttribute((const void*)fwd_kernel, hipFuncAttributeMaxDynamicSharedMemorySize, LDS_BYTES) != hipSuccess) { fprintf(stderr, "kernel_launch: hipFuncSetAttribute failed\n"); grid = -1; return; }
        if (hipOccupancyMaxActiveBlocksPerMultiprocessor(&per_cu, (const void*)fwd_kernel, NTHR, LDS_BYTES) != hipSuccess || per_cu < 1) fprintf(stderr, "kernel_launch: occupancy query says %d\n", per_cu);
        (void)hipGetLastError();
        grid = cus;
    }
    if (grid < 0) return;
    (void)hipMemsetAsync((char*)d_ws + WS_CTL, 0, CTL_ZERO_BYTES, stream);
    Args a{};
    for (int i = 0; i < 34; ++i) a.in[i] = (const float*)d_in[i];
    a.out = (float*)d_out; a.ws = (unsigned char*)d_ws;
#ifndef ONE_LAUNCH
#define ONE_LAUNCH 1
#endif
#ifndef PROBE_PREFIX
#define PROBE_PREFIX 0
#endif
    if (PROBE_PREFIX > 0) { a.ph_lo = 0; a.ph_hi = PROBE_PREFIX; hipLaunchKernelGGL(fwd_kernel, dim3(grid), dim3(NTHR), LDS_BYTES, stream, a); (void)hipMemsetAsync((char*)d_ws + WS_CTL, 0, CTL_ZERO_BYTES, stream); }
    if (ONE_LAUNCH) { a.ph_lo = 0; a.ph_hi = N_PHASES; hipLaunchKernelGGL(fwd_kernel, dim3(grid), dim3(NTHR), LDS_BYTES, stream, a); }
    else for (int ph = 0; ph < N_PHASES; ++ph) { a.ph_lo = ph; a.ph_hi = ph + 1; hipLaunchKernelGGL(fwd_kernel, dim3(grid), dim3(NTHR), LDS_BYTES, stream, a); }
}
```

```cpp
#include <hip/hip_runtime.h>
#include <cstdio>
#include <cstdint>
#define LAS __attribute__((address_space(3)))
#define GAS __attribute__((address_space(1)))
namespace pg8 {
#define PG8_LAS __attribute__((address_space(3)))
typedef unsigned short bf16_t;
typedef short bf16x8 __attribute__((ext_vector_type(8)));
typedef float f32x4 __attribute__((ext_vector_type(4)));
typedef unsigned u32x4 __attribute__((ext_vector_type(4)));
constexpr int BM = 256, BK = 64, HALF = 128, HTB = HALF * BK * 2  , STAGE_BYTES = 8 * HTB, NXCD = 8, WGM = 8;

__host__ __device__ __forceinline__ int lds_byte(int r, int c) { const int st = (r >> 4) * 2 + (c >> 5), rr = r & 15, cc = c & 31, ob = rr * 64 + cc * 2; return st * 1024 + (ob ^ (((ob >> 9) & 1) << 5)); }
__host__ __device__ __forceinline__ void stage_rc(int b, int& R, int& C) { const int st = b / 1024, sb = b % 1024, swz = sb ^ (((sb >> 9) & 1) << 5); R = (st >> 1) * 16 + swz / 64; C = (st & 1) * 32 + (swz % 64) / 2; }
__host__ __device__ __forceinline__ int perm32(int rho) { const int n = rho >> 4, i = rho & 15; return 8 * (i >> 2) + 4 * n + (i & 3); }

struct Unit { int pm, pn, kh, idx; };
struct Gemm { const bf16_t* A; const bf16_t* Bt; int M, N, K, ld; };

struct StaticOrder {
    int nM, nN, nNr, nwg, G, c;
    __host__ __device__ void init(int M, int N, int G_, int c_, int ksplit = 1, int bn = BM) { nM = M / BM; nNr = N / bn; nN = nNr * ksplit; nwg = nM * nN; G = G_; c = c_; }
    __host__ __device__ bool next(int i, Unit& u) const {
        const long L = (long)i * G + c; if (L >= nwg) return false;
        int wgid = (int)L; { const int q = nwg / NXCD, r = nwg % NXCD, xcd = wgid % NXCD, off = wgid / NXCD; wgid = (xcd < r ? xcd * (q + 1) : r * (q + 1) + (xcd - r) * q) + off; }
        const int nig = WGM * nN, gid = wgid / nig, fm = gid * WGM, gsz = (nM - fm) < WGM ? (nM - fm) : WGM;
        u.pm = fm + ((wgid % nig) % gsz); const int pnr = (wgid % nig) / gsz; u.pn = pnr % nNr; u.kh = pnr / nNr; u.idx = i; return true;
    }
    __device__ __forceinline__ void a_ready(const Unit&) const {}
    __device__ __forceinline__ void done(const Unit&) const {}
};

__device__ __forceinline__ unsigned cvt_pk_bf16(float lo, float hi) { unsigned r; asm volatile("v_cvt_pk_bf16_f32 %0, %1, %2" : "=v"(r) : "v"(lo), "v"(hi)); return r; }
typedef float f32x2 __attribute__((ext_vector_type(2)));
template <class Epi, class Sched, bool ALIGN_EPI = false, bool SP2 = false, bool NB1 = false>
__device__ __forceinline__ void gemm_phase(PG8_LAS unsigned char* lds, const Gemm g, const Sched& S, const Epi& E, const int tid) {
    const int wid = __builtin_amdgcn_readfirstlane(tid >> 6), lane = tid & 63, wr = wid >> 2, wc = wid & 3, fr = lane & 15, fq = lane >> 4;
    const int K = g.K, ld = g.ld, nt = K / BK;
    unsigned voffA[2], voffB[2];
#pragma unroll
    for (int i = 0; i < 2; ++i) { int R, C; stage_rc(tid * 16 + i * 8192, R, C); const int Rb = Epi::PERM ? ((R & ~31) + perm32(R & 31)) : R;
        voffA[i] = (unsigned)(R * ld + C) * 2u; voffB[i] = (unsigned)(Rb * ld + C) * 2u; }
    const size_t kstep = (size_t)(BK * 2);
    const size_t hstep = (size_t)HALF * ld * 2;
    const size_t tstep = 2 * hstep;
    const unsigned ldsw = (unsigned)wid * 1024u;
    const int aoff = lds_byte(wr * 64 + fr, fq * 8), boff = lds_byte(wc * 32 + fr, fq * 8);
#define PG8_SA(b, h) (((b) * 2 + (h)) * HTB)
#define PG8_SB(b, h) ((4 + (b) * 2 + (h)) * HTB)
#define PG8_STAGE(bufoff, gbase, voff) do { _Pragma("unroll") for (int _i = 0; _i < 2; ++_i) \
        __builtin_amdgcn_global_load_lds((const unsigned*)((const char*)(gbase) + (voff)[_i]), (PG8_LAS unsigned*)(lds + (bufoff) + ldsw + _i * 8192), 16, 0, 0); } while (0)
#define PG8_LDA(dst, b, h) do { _Pragma("unroll") for (int m = 0; m < 4; ++m) _Pragma("unroll") for (int k = 0; k < 2; ++k) dst[m][k] = *(const PG8_LAS bf16x8*)(lds + PG8_SA(b, h) + aoff + m * 2048 + k * 1024); } while (0)
#define PG8_LDB(dst, b, h) do { _Pragma("unroll") for (int n = 0; n < 2; ++n) _Pragma("unroll") for (int k = 0; k < 2; ++k) dst[n][k] = *(const PG8_LAS bf16x8*)(lds + PG8_SB(b, h) + boff + n * 2048 + k * 1024); } while (0)
#define PG8_MMA(ai, bj, At, Bt) do { __builtin_amdgcn_s_setprio(1); _Pragma("unroll") for (int m = 0; m < 4; ++m) _Pragma("unroll") for (int n = 0; n < 2; ++n) _Pragma("unroll") for (int k = 0; k < 2; ++k) \
        acc[ai][bj][m][n] = __builtin_amdgcn_mfma_f32_16x16x32_bf16(Bt[n][k], At[m][k], acc[ai][bj][m][n], 0, 0, 0); __builtin_amdgcn_s_setprio(0); } while (0)
#define PG8_WAIT_V(n) asm volatile("s_waitcnt vmcnt(" #n ")" ::: "memory")
#define PG8_WAIT_L(n) asm volatile("s_waitcnt lgkmcnt(" #n ")" ::: "memory")
#define PG8_BAR __builtin_amdgcn_s_barrier()
#define PG8_SCHED __builtin_amdgcn_sched_barrier(0)
    Unit cur, nxt; int ui = 0;
    if (!S.next(0, cur)) return;
    f32x4 acc[2][2][4][2];
#pragma unroll
    for (int a = 0; a < 2; ++a)
#pragma unroll
        for (int b = 0; b < 2; ++b)
#pragma unroll
            for (int m = 0; m < 4; ++m)
#pragma unroll
                for (int n = 0; n < 2; ++n) acc[a][b][m][n] = (f32x4){0.f, 0.f, 0.f, 0.f};
    bf16x8 At[4][2], B0[2][2], B1[2][2];
    const char* cA = (const char*)g.A + (size_t)cur.pm * tstep + (size_t)cur.kh * K * 2; const char* cB = (const char*)g.Bt + (size_t)cur.pn * (NB1 ? hstep : tstep) + (size_t)cur.kh * K * 2;
    S.a_ready(cur);
    if constexpr (SP2) {
        PG8_STAGE(PG8_SB(0, 0), cB, voffB); if constexpr (!NB1) PG8_STAGE(PG8_SB(0, 1), cB + hstep, voffB); PG8_STAGE(PG8_SA(0, 0), cA, voffA); PG8_STAGE(PG8_SA(0, 1), cA + hstep, voffA);
        if (wr == 1) PG8_BAR;
        PG8_WAIT_V(2); PG8_BAR;
        PG8_STAGE(PG8_SB(1, 0), cB + kstep, voffB); PG8_STAGE(PG8_SA(1, 0), cA + kstep, voffA); if constexpr (!NB1) PG8_STAGE(PG8_SB(1, 1), cB + hstep + kstep, voffB);
        if constexpr (NB1) PG8_WAIT_V(4); else PG8_WAIT_V(6);
        PG8_BAR;
    } else {
        PG8_STAGE(PG8_SB(0, 0), cB, voffB); PG8_STAGE(PG8_SA(0, 0), cA, voffA); PG8_STAGE(PG8_SB(0, 1), cB + hstep, voffB); PG8_STAGE(PG8_SA(0, 1), cA + hstep, voffA);
        if (wr == 1) PG8_BAR;
        PG8_WAIT_V(4); PG8_BAR;
        PG8_STAGE(PG8_SB(1, 0), cB + kstep, voffB); PG8_STAGE(PG8_SA(1, 0), cA + kstep, voffA); PG8_STAGE(PG8_SB(1, 1), cB + hstep + kstep, voffB);
        PG8_WAIT_V(6); PG8_BAR;
    }
    for (;;) {
        const bool has_next = S.next(ui + 1, nxt);
        const char* nA = has_next ? (const char*)g.A + (size_t)nxt.pm * tstep + (size_t)nxt.kh * K * 2 : cA; const char* nB = has_next ? (const char*)g.Bt + (size_t)nxt.pn * (NB1 ? hstep : tstep) + (size_t)nxt.kh * K * 2 : cB;
        for (int t = 0; t < nt; t += 2) {
            const bool last = (t == nt - 2);
            const char* a1 = cA + (size_t)(t + 1) * kstep;
            const char* a2 = last ? nA : cA + (size_t)(t + 2) * kstep; const char* b2 = last ? nB : cB + (size_t)(t + 2) * kstep;
            const char* a3 = a2 + kstep; const char* b3 = b2 + kstep;
            if (last && has_next) S.a_ready(nxt);
            if constexpr (SP2) {
            if constexpr (!NB1) {
            PG8_LDB(B0, 0, 0); PG8_LDB(B1, 0, 1); PG8_SCHED; PG8_LDA(At, 0, 0); PG8_STAGE(PG8_SA(1, 1), a1 + hstep, voffA);
            PG8_WAIT_V(8); PG8_WAIT_L(0); PG8_BAR; PG8_MMA(0, 0, At, B0); PG8_MMA(0, 1, At, B1); PG8_BAR; PG8_SCHED;
            PG8_LDA(At, 0, 1); PG8_STAGE(PG8_SB(0, 0), b2, voffB); PG8_STAGE(PG8_SB(0, 1), b2 + hstep, voffB); PG8_STAGE(PG8_SA(0, 0), a2, voffA);
            PG8_WAIT_V(8); PG8_WAIT_L(0); PG8_BAR; PG8_MMA(1, 0, At, B0); PG8_MMA(1, 1, At, B1); PG8_BAR; PG8_SCHED;
            PG8_LDB(B0, 1, 0); PG8_LDB(B1, 1, 1); PG8_SCHED; PG8_LDA(At, 1, 0); PG8_STAGE(PG8_SA(0, 1), a2 + hstep, voffA);
            PG8_WAIT_V(8); PG8_WAIT_L(0); PG8_BAR; PG8_MMA(0, 0, At, B0); PG8_MMA(0, 1, At, B1); PG8_BAR; PG8_SCHED;
            PG8_LDA(At, 1, 1); PG8_STAGE(PG8_SB(1, 0), b3, voffB); PG8_STAGE(PG8_SB(1, 1), b3 + hstep, voffB); PG8_STAGE(PG8_SA(1, 0), a3, voffA);
            PG8_WAIT_V(8); PG8_WAIT_L(0); PG8_BAR; PG8_MMA(1, 0, At, B0); PG8_MMA(1, 1, At, B1); PG8_BAR; PG8_SCHED;
            } else {
            PG8_LDB(B0, 0, 0); PG8_SCHED; PG8_LDA(At, 0, 0); PG8_STAGE(PG8_SA(1, 1), a1 + hstep, voffA);
            PG8_WAIT_V(6); PG8_WAIT_L(0); PG8_BAR; PG8_MMA(0, 0, At, B0); PG8_BAR; PG8_SCHED;
            PG8_LDA(At, 0, 1); PG8_STAGE(PG8_SB(0, 0), b2, voffB); PG8_STAGE(PG8_SA(0, 0), a2, voffA);
            PG8_WAIT_V(6); PG8_WAIT_L(0); PG8_BAR; PG8_MMA(1, 0, At, B0); PG8_BAR; PG8_SCHED;
            PG8_LDB(B0, 1, 0); PG8_SCHED; PG8_LDA(At, 1, 0); PG8_STAGE(PG8_SA(0, 1), a2 + hstep, voffA);
            PG8_WAIT_V(6); PG8_WAIT_L(0); PG8_BAR; PG8_MMA(0, 0, At, B0); PG8_BAR; PG8_SCHED;
            PG8_LDA(At, 1, 1); PG8_STAGE(PG8_SB(1, 0), b3, voffB); PG8_STAGE(PG8_SA(1, 0), a3, voffA);
            PG8_WAIT_V(6); PG8_WAIT_L(0); PG8_BAR; PG8_MMA(1, 0, At, B0); PG8_BAR; PG8_SCHED;
            }
            } else {
            PG8_LDB(B0, 0, 0); PG8_SCHED; PG8_LDA(At, 0, 0); PG8_STAGE(PG8_SA(1, 1), a1 + hstep, voffA);
            PG8_WAIT_L(8); PG8_BAR; PG8_WAIT_L(0); PG8_MMA(0, 0, At, B0); PG8_BAR; PG8_SCHED;
            PG8_LDB(B1, 0, 1); PG8_STAGE(PG8_SB(0, 0), b2, voffB);
            PG8_BAR; PG8_WAIT_L(0); PG8_MMA(0, 1, At, B1); PG8_BAR;
            PG8_LDA(At, 0, 1); PG8_STAGE(PG8_SA(0, 0), a2, voffA);
            PG8_BAR; PG8_WAIT_L(0); PG8_MMA(1, 0, At, B0); PG8_BAR; PG8_SCHED;
            PG8_STAGE(PG8_SB(0, 1), b2 + hstep, voffB);
            PG8_WAIT_V(6); PG8_BAR; PG8_MMA(1, 1, At, B1); PG8_BAR;
            PG8_LDB(B0, 1, 0); PG8_SCHED; PG8_LDA(At, 1, 0); PG8_STAGE(PG8_SA(0, 1), a2 + hstep, voffA);
            PG8_WAIT_L(8); PG8_BAR; PG8_WAIT_L(0); PG8_MMA(0, 0, At, B0); PG8_BAR; PG8_SCHED;
            PG8_LDB(B1, 1, 1); PG8_STAGE(PG8_SB(1, 0), b3, voffB);
            PG8_BAR; PG8_WAIT_L(0); PG8_MMA(0, 1, At, B1); PG8_BAR;
            PG8_LDA(At, 1, 1); PG8_STAGE(PG8_SA(1, 0), a3, voffA);
            PG8_BAR; PG8_WAIT_L(0); PG8_MMA(1, 0, At, B0); PG8_BAR; PG8_SCHED;
            PG8_STAGE(PG8_SB(1, 1), b3 + hstep, voffB);
            PG8_WAIT_V(6); PG8_BAR; PG8_MMA(1, 1, At, B1); PG8_BAR;
            }
        }
        if constexpr (ALIGN_EPI) { if (wr == 0) PG8_BAR; }
        if constexpr (!Epi::AFTER_DRAIN) { E(acc, cur, wr, wc, fr, fq); S.done(cur); }
        if (!has_next) break;
#pragma unroll
        for (int a = 0; a < 2; ++a)
#pragma unroll
            for (int b = 0; b < 2; ++b)
#pragma unroll
                for (int m = 0; m < 4; ++m)
#pragma unroll
                    for (int n = 0; n < 2; ++n) acc[a][b][m][n] = (f32x4){0.f, 0.f, 0.f, 0.f};
        cur = nxt; cA = nA; cB = nB; ++ui;
        if constexpr (ALIGN_EPI) { if (wr == 1) PG8_BAR; }
    }
    PG8_WAIT_V(0);
    if constexpr (!ALIGN_EPI) { if (wr == 0) PG8_BAR; }
    PG8_BAR;
    if constexpr (Epi::AFTER_DRAIN) { E.fused(acc, cur, wr, wc, fr, fq, lds, wid, lane); S.done(cur); }
#undef PG8_SA
#undef PG8_SB
#undef PG8_STAGE
#undef PG8_LDA
#undef PG8_LDB
#undef PG8_MMA
#undef PG8_WAIT_V
#undef PG8_WAIT_L
#undef PG8_BAR
#undef PG8_SCHED
}
}
#define XB_TMO      128
#define XB_XCNT(j)  (256  + 64 * (j))
#define XB_XSUB(j)  (1280 + 64 * (j))
#define XB_XGEN(j)  (2304 + 64 * (j))
#define XB_TOP      3328
#define XB_TOPGEN   3392
#define XCD_BAR_WORDS 3456
#define XB_SPIN_CAP (1u << 18)

__device__ __forceinline__ unsigned xb_ld(unsigned* p)              { return __hip_atomic_load(p, __ATOMIC_RELAXED, __HIP_MEMORY_SCOPE_AGENT); }
__device__ __forceinline__ unsigned xb_add(unsigned* p, unsigned v) { return __hip_atomic_fetch_add(p, v, __ATOMIC_RELAXED, __HIP_MEMORY_SCOPE_AGENT); }
__device__ __forceinline__ unsigned xb_xcc_id() { return (unsigned)__builtin_amdgcn_s_getreg((3 << 11) | 20) & 0xFu; }
#define XB_SPIN(cond, bar) do { unsigned _sp = 0; while (cond) { __builtin_amdgcn_s_sleep(1); \
    if ((++_sp & 255u) == 0u) { if (xb_ld(&(bar)[XB_TMO])) break; if (_sp > XB_SPIN_CAP) { atomicAdd(&(bar)[XB_TMO], 1u); break; } } } } while (0)

struct XcdBarrier {
    unsigned* bar; unsigned x;
    volatile LAS unsigned* st;
};

__device__ __forceinline__ XcdBarrier xcd_barrier_post(unsigned* bar, volatile LAS unsigned* st) {
    XcdBarrier b; b.bar = bar; b.x = xb_xcc_id(); b.st = st;
    if (threadIdx.x == 0) (void)xb_add(&bar[XB_XCNT(b.x)], 1u);
    return b;
}
__device__ __forceinline__ void xcd_barrier_complete(unsigned* bar, unsigned x, unsigned& nloc, unsigned& nx) {
    const unsigned G = gridDim.x * gridDim.y * gridDim.z;
    unsigned sum, cnt, mine, sp = 0u;
    for (;;) {
        sum = 0u; cnt = 0u; mine = 0u;
#pragma unroll
        for (unsigned j = 0; j < 16; ++j) { const unsigned c = xb_ld(&bar[XB_XCNT(j)]); sum += c; cnt += (c > 0u) ? 1u : 0u; mine = (j == x) ? c : mine; }
        if (sum == G) break;
        __builtin_amdgcn_s_sleep(1);
        if ((++sp & 255u) == 0u) { if (xb_ld(&bar[XB_TMO])) break; if (sp > XB_SPIN_CAP) { atomicAdd(&bar[XB_TMO], 1u); break; } }
    }
    nloc = mine > 0u ? mine : 1u; nx = cnt > 0u ? cnt : 1u;
}

__device__ __forceinline__ void xcd_barrier(const XcdBarrier& b) {
    asm volatile("s_waitcnt vmcnt(0)" ::: "memory");
    __syncthreads();
    if (threadIdx.x == 0) {
        unsigned* bar = b.bar;
        __builtin_amdgcn_s_waitcnt(0);
        unsigned nloc = b.st[0], nx = b.st[1];
        if (nloc == 0u) { xcd_barrier_complete(bar, b.x, nloc, nx); b.st[0] = nloc; b.st[1] = nx; }
        const unsigned old = xb_add(&bar[XB_XSUB(b.x)], 1u);
        const unsigned gen = old / nloc;
        if (old + 1u == (gen + 1u) * nloc) {
            __builtin_amdgcn_fence(__ATOMIC_RELEASE, "agent");
            asm volatile("s_waitcnt vmcnt(0)" ::: "memory");
            const unsigned og = xb_add(&bar[XB_TOP], 1u);
            const unsigned tg = og / nx;
            if (og + 1u == (tg + 1u) * nx) xb_add(&bar[XB_TOPGEN], 1u);
            else XB_SPIN(xb_ld(&bar[XB_TOPGEN]) == tg, bar);
            __builtin_amdgcn_fence(__ATOMIC_ACQUIRE, "agent");
            xb_add(&bar[XB_XGEN(b.x)], 1u);
            asm volatile("s_waitcnt vmcnt(0)" ::: "memory");
        } else {
            XB_SPIN(xb_ld(&bar[XB_XGEN(b.x)]) == gen, bar);
            __builtin_amdgcn_fence(__ATOMIC_ACQUIRE, "agent");
            asm volatile("s_waitcnt vmcnt(0)" ::: "memory");
        }
    }
    __syncthreads();
}
typedef unsigned short bf16;
typedef unsigned v4u __attribute__((ext_vector_type(4)));
typedef unsigned v2u __attribute__((ext_vector_type(2)));
typedef float f32x4 __attribute__((ext_vector_type(4)));
typedef float f32x2 __attribute__((ext_vector_type(2)));
constexpr int NWAVES = 8, NTHR = 512;
constexpr int D = 1024, FF = 2816, NGU = 2 * FF, NIN = 3120, NINP = 3328, M = 8192, MCTX = 4096;
constexpr int C_GQ = 0, C_GK = 128, C_GV = 256, C_GLRF = 512, C_GLRB = 528, C_GOG = 544, C_DQ = 800, C_DK = 1312, C_DV = 1824,
              C_DAF = 2336, C_DAB = 2340, C_DBF = 2344, C_DBB = 2348, C_DOG = 2352, C_SU = 2864;
constexpr size_t O_Y = 0, O_SGLA = (size_t)M * D, O_SGDN = O_SGLA + 524288, O_S5RE = O_SGDN + 4194304, O_S5IM = O_S5RE + 65536, O_END = O_S5IM + 65536;
constexpr size_t MiB = 1u << 20;
constexpr size_t WS_CTL = 0, CTL_ZERO_BYTES = 1 * MiB;
constexpr size_t WS_MOD = 1 * MiB;
constexpr size_t WS_WGU = 2 * MiB;
constexpr size_t WS_WD = 26 * MiB;
constexpr size_t WS_WIN = 37 * MiB;
constexpr size_t WS_WOUT = 44 * MiB;
constexpr size_t WS_HN = 46 * MiB;
constexpr size_t WS_PROJ = 62 * MiB;
constexpr size_t WS_H = 62 * MiB;
constexpr size_t WS_GR = 114 * MiB;
constexpr size_t WS_GQ = 146 * MiB;
constexpr size_t WS_GOQ = 178 * MiB;
constexpr size_t WS_OGDN = 194 * MiB;
constexpr size_t WS_HN2 = 210 * MiB;
constexpr size_t WS_OGLA = 226 * MiB;
constexpr size_t WS_YS5 = 242 * MiB;
constexpr size_t WS_GLADS = 258 * MiB;
constexpr size_t WS_GLASC = 266 * MiB;
constexpr size_t WS_GLADV = 274 * MiB;
constexpr size_t WS_S5E = 275 * MiB;
constexpr size_t WS_S5HS = 277 * MiB;
constexpr size_t WS_GEGL = 279 * MiB;
constexpr size_t WS_WGLU = 279 * MiB + 512 * 1024;
constexpr size_t WS_END = 280 * MiB;
constexpr int CW_BAR = 4096;
constexpr size_t WS_SUBBAR = 48 * 1024;
constexpr size_t WS_SS = 64 * 1024;
constexpr size_t WS_CW = WS_MOD + 256 * 1024;
constexpr size_t WS_BGU = WS_MOD + 512 * 1024;
constexpr size_t WS_BIN = WS_BGU + 2 * 3 * 5632 * 4;
constexpr int LDS_BYTES = 152 * 1024;
constexpr int LDS_CTL_OFF = 150 * 1024;

#define RLX_AGENT __ATOMIC_RELAXED, __HIP_MEMORY_SCOPE_AGENT
#if defined(__HIP_DEVICE_COMPILE__)
#define ASSUME_GLOBAL(p) __builtin_assume(!__builtin_amdgcn_is_shared((const void*)(p)) && !__builtin_amdgcn_is_private((const void*)(p)))
#else
#define ASSUME_GLOBAL(p) ((void)0)
#endif
__device__ __forceinline__ unsigned f2bf(float f) { unsigned u = __builtin_bit_cast(unsigned, f); return (u + 0x7fffu + ((u >> 16) & 1u)) >> 16; }
__device__ __forceinline__ unsigned pk2(float lo, float hi) { return f2bf(lo) | (f2bf(hi) << 16); }
__device__ __forceinline__ float bf2f(unsigned short h) { return __builtin_bit_cast(float, (unsigned)h << 16); }
__device__ __forceinline__ float bflo(unsigned u) { return __builtin_bit_cast(float, u << 16); }
__device__ __forceinline__ float bfhi(unsigned u) { return __builtin_bit_cast(float, u & 0xffff0000u); }
__device__ __forceinline__ float siluf(float x) { return x * __builtin_amdgcn_rcpf(1.0f + __expf(-x)); }
__device__ __forceinline__ float sigmf(float x) { return __builtin_amdgcn_rcpf(1.0f + __expf(-x)); }
__device__ __forceinline__ float softplusf(float x) { return fmaxf(x, 0.f) + __logf(1.0f + __expf(-fabsf(x))); }
__device__ __forceinline__ float wave_sum(float v) {
#pragma unroll
    for (int o = 1; o < 64; o <<= 1) v += __shfl_xor(v, o);
    return v;
}

struct Args { const float* in[34]; float* out; unsigned char* ws; int ph_lo, ph_hi; };
__device__ __forceinline__ float lane_read(float v, int src_lane) { return __builtin_bit_cast(float, __builtin_amdgcn_ds_bpermute(src_lane << 2, __builtin_bit_cast(int, v))); }
struct Ctx {
    LAS unsigned char* lds;
    int tid, lane, wave, vb, nb, vb_raw;
    unsigned char* ws; float* out;
    __device__ __forceinline__ unsigned long long ptab(int i) const { const volatile LAS unsigned* p = (const volatile LAS unsigned*)(lds + LDS_CTL_OFF + 256) + 2 * i;
        const unsigned lo = __builtin_amdgcn_readfirstlane(p[0]), hi = __builtin_amdgcn_readfirstlane(p[1]); return ((unsigned long long)hi << 32) | lo; }
    __device__ __forceinline__ const float* inp(int i) const { return (const float*)(GAS const float*)ptab(i); }
    __device__ __forceinline__ float* outp() const { return out; }
    __device__ __forceinline__ float* wsf(size_t off) const { return (float*)(ws + off); }
    __device__ __forceinline__ bf16* wsb(size_t off) const { return (bf16*)(ws + off); }
};
enum { I_XP = 0, I_XS, I_C, I_SGLA, I_SGDN, I_S5RE, I_S5IM, I_CCTX, I_WADA, I_BADA, I_NORMW, I_WG, I_WU, I_WDN, I_WIN, I_GKUP, I_GKB, I_GLANW, I_CONVW, I_ALOG, I_DTB, I_GDNNW,
       I_LRE, I_LIM, I_LSTEP, I_BRE, I_BIM, I_CRE, I_CIM, I_S5D, I_WGLU, I_BGLU, I_WOUT, I_FNW };

struct ChunkInfo { int row0, seq, c, nc, lat, clo, chi, gc0; };
__device__ __forceinline__ ChunkInfo chunk_info(int gc) {
    ChunkInfo ci; ci.row0 = gc * 64;
    if (gc < 64) { ci.seq = gc >> 2; ci.c = gc & 3; ci.nc = 4; ci.lat = 0; ci.clo = ci.seq * 256; ci.chi = ci.clo + 256; ci.gc0 = ci.seq * 4; }
    else { ci.seq = 16 + ((gc - 64) >> 5); ci.c = (gc - 64) & 31; ci.nc = 32; ci.lat = 1; ci.clo = ci.row0; ci.chi = ci.row0 + 64; ci.gc0 = 64 + (ci.seq - 16) * 32; }
    return ci;
}
__device__ __forceinline__ int row_cid(int row) { return row < MCTX ? 0 : 1 + ((row - MCTX) >> 11); }

__device__ __forceinline__ void load16bf(const bf16* p, float (&x)[16]) {
    const v4u a = *(const v4u*)p, b = *(const v4u*)(p + 8);
    x[0] = bflo(a.x); x[1] = bfhi(a.x); x[2] = bflo(a.y); x[3] = bfhi(a.y); x[4] = bflo(a.z); x[5] = bfhi(a.z); x[6] = bflo(a.w); x[7] = bfhi(a.w);
    x[8] = bflo(b.x); x[9] = bfhi(b.x); x[10] = bflo(b.y); x[11] = bfhi(b.y); x[12] = bflo(b.z); x[13] = bfhi(b.z); x[14] = bflo(b.w); x[15] = bfhi(b.w);
}
__device__ __forceinline__ void ph_mod(Ctx& C) {
    LAS float* scond = (LAS float*)C.lds;
    LAS float* red = scond + 3072;
    for (int i = C.tid; i < 3072; i += NTHR) { const int cid = i >> 10, k = i & 1023; const float v = cid == 0 ? C.inp(I_CCTX)[k] : C.inp(I_C)[(cid - 1) * 1024 + k]; scond[i] = siluf(v); }
    __syncthreads();
    const float* wada = C.inp(I_WADA); const float* bada = C.inp(I_BADA);
    for (int unit = C.vb; unit < 288; unit += C.nb) {
        const int l = unit / 144, cb = (unit % 144) * 64, col = cb + C.lane;
        const float* w = wada + (size_t)l * 1024 * 9216 + col;
        float a0 = 0.f, a1 = 0.f, a2 = 0.f; const int k0 = C.wave * 128;
#pragma unroll 8
        for (int k = k0; k < k0 + 128; ++k) { const float wv = w[(size_t)k * 9216]; a0 += scond[k] * wv; a1 += scond[1024 + k] * wv; a2 += scond[2048 + k] * wv; }
        red[(C.wave * 3 + 0) * 64 + C.lane] = a0; red[(C.wave * 3 + 1) * 64 + C.lane] = a1; red[(C.wave * 3 + 2) * 64 + C.lane] = a2;
        __syncthreads();
        if (C.tid < 192) { const int cid = C.tid >> 6, ln = C.tid & 63; float s = bada[l * 9216 + cb + ln];
#pragma unroll
            for (int w8 = 0; w8 < 8; ++w8) s += red[(w8 * 3 + cid) * 64 + ln];
            C.wsf(WS_MOD)[(l * 3 + cid) * 9216 + cb + ln] = s;
            const int chunk = cb >> 10; if (chunk % 3 == 1) { const int inst = chunk / 3, col = (cb & 1023) + ln; C.wsf(WS_CW)[((l * 3 + inst) * 3 + cid) * D + col] = C.inp(I_NORMW)[(l * 3 + inst) * D + col] * (1.f + s); } }
        __syncthreads();
    }
}

template <int MODE>
__device__ __forceinline__ void transpose_item(const float* W, int K, int N, int NPAD, bf16* WT, LAS float* scr, int item, int lane) {
    const int nblk = NPAD / 32, kb = item / nblk, nbk = item % nblk, k0 = 64 * kb, n0 = 32 * nbk;
#pragma unroll 8
    for (int i = 0; i < 32; ++i) { const int kk = 2 * i + (lane >> 5), n = n0 + (lane & 31); scr[kk * 33 + (lane & 31)] = (n < N) ? W[(size_t)(k0 + kk) * N + n] : 0.f; }
    asm volatile("s_waitcnt lgkmcnt(0)" ::: "memory");
    const int c = lane & 7;
#pragma unroll
    for (int j = 0; j < 4; ++j) { const int nn = (lane >> 3) + 8 * j; const LAS float* s = scr + (8 * c) * 33 + nn;
        v4u o; o.x = pk2(s[0 * 33], s[1 * 33]); o.y = pk2(s[2 * 33], s[3 * 33]); o.z = pk2(s[4 * 33], s[5 * 33]); o.w = pk2(s[6 * 33], s[7 * 33]);
        const int n = n0 + nn; const int row = MODE == 0 ? n : (MODE == 1 ? 8 * (n >> 2) + (n & 3) : 8 * (n >> 2) + 4 + (n & 3));
        *(v4u*)(WT + (size_t)row * K + k0 + 8 * c) = o; }
    asm volatile("s_waitcnt lgkmcnt(0)" ::: "memory");
}
__device__ __forceinline__ void ph_wconv(Ctx& C, int l) {
    LAS float* scr = (LAS float*)(C.lds + C.wave * 8448);
    const int gw = C.vb * NWAVES + C.wave, NGW = C.nb * NWAVES;
    constexpr int I_G = 16 * 88, I_D = 44 * 32, I_IN = 16 * 104, I_O = 16 * 32, I_GL = 4 * 8;
    constexpr int NITEMS = 4 * I_G + 2 * I_D + I_IN + I_O + I_GL;
    for (int it = gw; it < NITEMS; it += NGW) {
        int r = it;
        if (r < 4 * I_G) { const int j = r / (2 * I_G), gu = (r / I_G) & 1; r %= I_G;
            const float* W = C.inp(gu ? I_WU : I_WG) + (size_t)(l * 2 + j) * D * FF; bf16* WT = C.wsb(WS_WGU) + (size_t)j * NGU * D;
            if (gu) transpose_item<2>(W, D, FF, FF, WT, scr, r, C.lane); else transpose_item<1>(W, D, FF, FF, WT, scr, r, C.lane); continue; }
        r -= 4 * I_G;
        if (r < 2 * I_D) { const int j = r / I_D; r %= I_D; transpose_item<0>(C.inp(I_WDN) + (size_t)(l * 2 + j) * FF * D, FF, D, D, C.wsb(WS_WD) + (size_t)j * D * FF, scr, r, C.lane); continue; }
        r -= 2 * I_D;
        if (r < I_IN) { transpose_item<0>(C.inp(I_WIN) + (size_t)l * D * NIN, D, NIN, NINP, C.wsb(WS_WIN), scr, r, C.lane); continue; }
        r -= I_IN;
        if (r < I_O) { transpose_item<0>(C.inp(I_WOUT) + (size_t)l * D * D, D, D, D, C.wsb(WS_WOUT), scr, r, C.lane); continue; }
        r -= I_O;
        transpose_item<0>(C.inp(I_WGLU) + (size_t)l * 65536, 256, 256, 256, C.wsb(WS_WGLU), scr, r, C.lane);
    }
}

__device__ __forceinline__ void ph_bias(Ctx& C, int l) {
    const int gw = C.vb * NWAVES + C.wave, NGW = C.nb * NWAVES, lane = C.lane;
    const float* MOD = C.wsf(WS_MOD);
    for (int part = 0; part < 3; ++part) {
        const int inst = part == 0 ? 0 : (part == 1 ? 2 : 1), nrows = part < 2 ? NGU : NINP;
        const bf16* W = part < 2 ? C.wsb(WS_WGU) + (size_t)part * NGU * D : C.wsb(WS_WIN);
        float* out = part < 2 ? C.wsf(WS_BGU) + (size_t)part * 3 * NGU : C.wsf(WS_BIN);
        float sh[3][16];
#pragma unroll
        for (int cid = 0; cid < 3; ++cid)
#pragma unroll
            for (int k = 0; k < 4; ++k) { const f32x4 v = *(const f32x4*)(MOD + (l * 3 + cid) * 9216 + (inst * 3) * D + lane * 16 + 4 * k); sh[cid][4 * k] = v.x; sh[cid][4 * k + 1] = v.y; sh[cid][4 * k + 2] = v.z; sh[cid][4 * k + 3] = v.w; }
        for (int n = gw; n < nrows; n += NGW) { float w[16]; load16bf(W + (size_t)n * D + lane * 16, w);
            float a0 = 0.f, a1 = 0.f, a2 = 0.f;
#pragma unroll
            for (int k = 0; k < 16; ++k) { a0 += w[k] * sh[0][k]; a1 += w[k] * sh[1][k]; a2 += w[k] * sh[2][k]; }
            a0 = wave_sum(a0); a1 = wave_sum(a1); a2 = wave_sum(a2);
            if (lane == 0) { out[n] = a0; out[nrows + n] = a1; out[2 * nrows + n] = a2; } }
    }
}
__device__ __forceinline__ void ph_xb0(Ctx& C) {
    const int gw = C.vb * NWAVES + C.wave, NGW = C.nb * NWAVES;
    const float* x0 = C.inp(I_XP); const float* x1 = C.inp(I_XS); bf16* HN = C.wsb(WS_HN); float* SS = (float*)(C.ws + WS_SS); const float* CW = C.wsf(WS_CW);
    for (int m = gw; m < M; m += NGW) {
        const int cid = row_cid(m); const float* xr = m < MCTX ? x0 + (size_t)m * D : x1 + (size_t)(m - MCTX) * D; const float* cw = CW + cid * D;
        float ss = 0.f;
#pragma unroll
        for (int j = 0; j < 4; ++j) { const int c0 = C.lane * 4 + 256 * j; const f32x4 v = *(const f32x4*)(xr + c0), w4 = *(const f32x4*)(cw + c0);
            ss += (v.x * v.x + v.y * v.y) + (v.z * v.z + v.w * v.w);
            v2u o; o.x = pk2(v.x * w4.x, v.y * w4.y); o.y = pk2(v.z * w4.z, v.w * w4.w); *(v2u*)(HN + (size_t)m * D + c0) = o; }
        ss = wave_sum(ss); if (C.lane == 0) SS[m] = ss;
    }
}
__device__ __forceinline__ void ph_final(Ctx& C) {
    const int gw = C.vb * NWAVES + C.wave, NGW = C.nb * NWAVES;
    const float* nw = C.inp(I_FNW);
    for (int m = gw; m < M; m += NGW) {
        float* xr = C.outp() + (size_t)m * D;
        f32x4 v[4]; float ss = 0.f;
#pragma unroll
        for (int j = 0; j < 4; ++j) { v[j] = *(const f32x4*)(xr + C.lane * 4 + 256 * j); ss += (v[j].x * v[j].x + v[j].y * v[j].y) + (v[j].z * v[j].z + v[j].w * v[j].w); }
        const float rstd = 1.0f / sqrtf(wave_sum(ss) * (1.f / D) + 1e-6f);
#pragma unroll
        for (int j = 0; j < 4; ++j) { const int c0 = C.lane * 4 + 256 * j; const f32x4 w4 = *(const f32x4*)(nw + c0);
            f32x4 o; o.x = v[j].x * rstd * w4.x; o.y = v[j].y * rstd * w4.y; o.z = v[j].z * rstd * w4.z; o.w = v[j].w * rstd * w4.w; *(f32x4*)(xr + c0) = o; }
    }
}

namespace pg8 {
struct EpiGU {
    static constexpr bool PERM = true, AFTER_DRAIN = false;
    bf16_t* Hout; const PG8_LAS float* ep;
    __device__ __forceinline__ void operator()(const f32x4 (&acc)[2][2][4][2], const Unit& u, int wr, int wc, int fr, int fq) const {
        const int row0 = u.pm * BM + wr * 64 + fr, hcol0 = u.pn * 128 + wc * 16 + 4 * fq;
        const PG8_LAS float* e = ep + u.idx * 512;
        f32x4 bg[2], bu[2];
#pragma unroll
        for (int bj = 0; bj < 2; ++bj) { bg[bj] = *(const PG8_LAS f32x4*)(e + 256 + wc * 32 + 8 * fq + bj * HALF); bu[bj] = *(const PG8_LAS f32x4*)(e + 256 + wc * 32 + 8 * fq + bj * HALF + 4); }
#pragma unroll
        for (int ai = 0; ai < 2; ++ai)
#pragma unroll
            for (int m = 0; m < 4; ++m) { const int rl = wr * 64 + fr + ai * HALF + m * 16; const float rs = e[rl]; bf16_t* rowp = Hout + (size_t)(u.pm * BM + rl) * FF + hcol0;
#pragma unroll
                for (int bj = 0; bj < 2; ++bj) { const f32x4 g = acc[ai][bj][m][0] * rs + bg[bj], uu = acc[ai][bj][m][1] * rs + bu[bj];
                    v2u w; w.x = cvt_pk_bf16(siluf(g[0]) * uu[0], siluf(g[1]) * uu[1]); w.y = cvt_pk_bf16(siluf(g[2]) * uu[2], siluf(g[3]) * uu[3]);
                    *(v2u*)(rowp + bj * 64) = w; } }
    }
};
template <bool NB1> struct EpiRes {
    static constexpr bool PERM = false, AFTER_DRAIN = false;
    const float* base0; const float* base1; float* X; bf16_t* XB; float* SS; const float* cw; const float* gate; float scale;
    __device__ __forceinline__ void operator()(const f32x4 (&acc)[2][2][4][2], const Unit& u, int wr, int wc, int fr, int fq) const {
        const int row0 = u.pm * BM + wr * 64 + fr, col0 = u.pn * (NB1 ? HALF : BM) + wc * 32 + 4 * fq; constexpr int NBJ = NB1 ? 1 : 2;
        const int cid = u.pm < 16 ? 0 : 1 + ((u.pm - 16) >> 3);
        f32x4 gv[2][2], cv[2][2];
#pragma unroll
        for (int bj = 0; bj < NBJ; ++bj)
#pragma unroll
            for (int n = 0; n < 2; ++n) { gv[bj][n] = *(const f32x4*)(gate + cid * 9216 + col0 + bj * HALF + n * 16) * scale; cv[bj][n] = cw ? *(const f32x4*)(cw + cid * D + col0 + bj * HALF + n * 16) : (f32x4){0.f, 0.f, 0.f, 0.f}; }
#pragma unroll
        for (int ai = 0; ai < 2; ++ai)
#pragma unroll
            for (int m = 0; m < 4; ++m) { const int row = row0 + ai * HALF + m * 16;
                const float* bp = (row < MCTX ? base0 + (size_t)row * D : base1 + (size_t)(row - MCTX) * D) + col0; float* xp = X + (size_t)row * D + col0; float ss = 0.f;
#pragma unroll
                for (int bj = 0; bj < NBJ; ++bj)
#pragma unroll
                    for (int n = 0; n < 2; ++n) { const f32x4 xn = *(const f32x4*)(bp + bj * HALF + n * 16) + gv[bj][n] * acc[ai][bj][m][n]; *(f32x4*)(xp + bj * HALF + n * 16) = xn;
                        if (cw) { ss += (xn[0] * xn[0] + xn[1] * xn[1]) + (xn[2] * xn[2] + xn[3] * xn[3]); const f32x4 y = xn * cv[bj][n];
                            v2u o; o.x = cvt_pk_bf16(y[0], y[1]); o.y = cvt_pk_bf16(y[2], y[3]); *(v2u*)(XB + (size_t)row * D + col0 + bj * HALF + n * 16) = o; } }
                if (cw) { ss += __shfl_xor(ss, 16); ss += __shfl_xor(ss, 32); if (fq == 0) atomicAdd(SS + row, ss); } }
    }
};
struct EpiProj {
    static constexpr bool PERM = true, AFTER_DRAIN = false;
    bf16_t* O; int ldc; const PG8_LAS float* ep;
    __device__ __forceinline__ void operator()(const f32x4 (&acc)[2][2][4][2], const Unit& u, int wr, int wc, int fr, int fq) const {
        const int col0 = u.pn * BM + wc * 32 + 8 * fq;
        const PG8_LAS float* e = ep + u.idx * 512;
        f32x4 b0[2], b1[2];
#pragma unroll
        for (int bj = 0; bj < 2; ++bj) { b0[bj] = *(const PG8_LAS f32x4*)(e + 256 + wc * 32 + 8 * fq + bj * HALF); b1[bj] = *(const PG8_LAS f32x4*)(e + 256 + wc * 32 + 8 * fq + bj * HALF + 4); }
#pragma unroll
        for (int ai = 0; ai < 2; ++ai)
#pragma unroll
            for (int m = 0; m < 4; ++m) { const int rl = wr * 64 + fr + ai * HALF + m * 16; const float rs = e[rl]; bf16_t* rowp = O + (size_t)(u.pm * BM + rl) * ldc + col0;
#pragma unroll
                for (int bj = 0; bj < 2; ++bj) { const f32x4 v0 = acc[ai][bj][m][0] * rs + b0[bj], v1 = acc[ai][bj][m][1] * rs + b1[bj];
                    u32x4 w; w.x = cvt_pk_bf16(v0[0], v0[1]); w.y = cvt_pk_bf16(v0[2], v0[3]); w.z = cvt_pk_bf16(v1[0], v1[1]); w.w = cvt_pk_bf16(v1[2], v1[3]);
                    *(u32x4*)(rowp + bj * HALF) = w; } }
    }
};
}

__device__ __forceinline__ void lds8bf(const LAS bf16* p, float (&x)[8]) {
    const v4u a = *(const LAS v4u*)p;
    x[0] = bflo(a.x); x[1] = bfhi(a.x); x[2] = bflo(a.y); x[3] = bfhi(a.y); x[4] = bflo(a.z); x[5] = bfhi(a.z); x[6] = bflo(a.w); x[7] = bfhi(a.w);
}

typedef short bf16x8 __attribute__((ext_vector_type(8)));
#define MFMA16(a, b, c) __builtin_amdgcn_mfma_f32_16x16x32_bf16((a), (b), (c), 0, 0, 0)
__device__ __forceinline__ int t128_off(int row, int col) { return row * 256 + (((col >> 3) ^ (row & 15)) << 4) + (col & 7) * 2; }
__device__ __forceinline__ int t64_off(int row, int col) { return row * 128 + (((col >> 3) ^ ((row >> 1) & 7)) << 4) + (col & 7) * 2; }
__device__ __forceinline__ int lo64(int lane, int ks) { const int r = lane & 15, q = lane >> 4; return r * 128 + (((4 * ks + q) ^ ((r >> 1) & 7)) << 4); }
__device__ __forceinline__ int lo128(int lane, int ks) { const int r = lane & 15, q = lane >> 4; return r * 256 + (((4 * ks + q) ^ r) << 4); }
__device__ __forceinline__ bf16x8 frag128(const LAS unsigned char* T, int r0, int k0, int lane) { return *(const LAS bf16x8*)(T + r0 * 256 + lo128(lane, k0 >> 5)); }
__device__ __forceinline__ bf16x8 frag64(const LAS unsigned char* T, int r0, int k0, int lane) { return *(const LAS bf16x8*)(T + r0 * 128 + lo64(lane, k0 >> 5)); }

__device__ __forceinline__ void gdn_inverse_blk(LAS unsigned char* Lb, int L0off, int TKoff, const LAS float* SG, int tid) {
    const int d = tid >> 8, tl = tid & 255, wl = __builtin_amdgcn_readfirstlane(tl >> 6), lane = tid & 63, q = lane >> 4, c = lane & 15;
    const LAS float* Lm = (const LAS float*)(Lb + L0off + d * 16384);
    LAS float* Tf = (LAS float*)(Lb + TKoff + d * 16384);
    {
        const LAS float* Ld = Lm + (wl * 16) * 64 + wl * 16; float x[16];
#pragma unroll
        for (int i = 0; i < 16; ++i) { float a = (i == c) ? 1.f : 0.f;
#pragma unroll
            for (int j = 0; j < i; ++j) a -= Ld[i * 64 + j] * x[j];
            x[i] = a; }
#pragma unroll
        for (int i = 0; i < 16; ++i) Tf[(wl * 16 + i) * 64 + wl * 16 + c] = x[i]; }
    __syncthreads();
#pragma unroll
    for (int dist = 1; dist < 4; ++dist) {
        if (wl + dist < 4) { const int j = wl, i = wl + dist;
            f32x4 P = {0.f, 0.f, 0.f, 0.f};
            for (int k = j; k < i; ++k) {
#pragma unroll
                for (int ks = 0; ks < 4; ++ks) P = __builtin_amdgcn_mfma_f32_16x16x4f32(Lm[(i * 16 + c) * 64 + k * 16 + 4 * ks + q], Tf[(k * 16 + 4 * ks + q) * 64 + j * 16 + c], P, 0, 0, 0); }
            f32x4 T = {0.f, 0.f, 0.f, 0.f};
#pragma unroll
            for (int ks = 0; ks < 4; ++ks) T = __builtin_amdgcn_mfma_f32_16x16x4f32(-Tf[(i * 16 + c) * 64 + i * 16 + 4 * q + ks], P[ks], T, 0, 0, 0);
#pragma unroll
            for (int r = 0; r < 4; ++r) Tf[(i * 16 + 4 * q + r) * 64 + j * 16 + c] = T[r]; }
        __syncthreads();
    }
    float vals[16];
#pragma unroll
    for (int k = 0; k < 16; ++k) { const int idx = tl + 256 * k, u = idx >> 6, v = idx & 63; vals[k] = ((v >> 4) <= (u >> 4)) ? Tf[u * 64 + v] : 0.f; }
    __syncthreads();
    LAS unsigned char* TK = Lb + TKoff + d * 16384; LAS unsigned char* TV = TK + 8192;
#pragma unroll
    for (int k = 0; k < 16; ++k) { const int idx = tl + 256 * k, u = idx >> 6, v = idx & 63, t = d ? 63 - u : u, sidx = d ? 63 - v : v;
        const float sv = SG[128 + d * 64 + sidx], sk = sv * SG[256 + d * 64 + sidx];
        *(LAS bf16*)(TK + t64_off(t, sidx)) = (bf16)f2bf(vals[k] * sk); *(LAS bf16*)(TV + t64_off(t, sidx)) = (bf16)f2bf(vals[k] * sv); }
}

__device__ __forceinline__ void gdn_prep_item(Ctx& C, int l, int gc, int h) {
    LAS unsigned char* L = C.lds;
    constexpr int QB = 0, KB = 16384, KT = 32768, VT = 49152, L0 = 65536, L1 = 81920, WT = 65536, UT = 81920, QKM0 = 98304, TK0 = 114688, SGO = 147456;
    LAS float* SG = (LAS float*)(L + SGO);
    const ChunkInfo ci = chunk_info(gc);
    int tid = C.tid; asm volatile("" : "+v"(tid));
    const int lane = tid & 63, w = C.wave, q = lane >> 4, c = lane & 15;
    const bf16* PROJ = C.wsb(WS_PROJ);
    {
        const int t = tid >> 3, sub = tid & 7, d0 = sub * 16, row = ci.row0 + t;
        const float* cwb = C.inp(I_CONVW) + (size_t)l * 5 * 1536 + h * 128 + d0;
        float msk[5]; int rcl[5];
#pragma unroll
        for (int j = 0; j < 5; ++j) { const int r = row + j - 2; msk[j] = (r >= ci.clo && r < ci.chi) ? 1.f : 0.f; rcl[j] = r < ci.clo ? ci.clo : (r >= ci.chi ? ci.chi - 1 : r); }
        v4u xa[5][2], xb[5][2];
#define GP_LOAD(X, which) { _Pragma("unroll") for (int j = 0; j < 5; ++j) { const bf16* pr = PROJ + (size_t)rcl[j] * NINP + C_DQ + (which) * 512 + h * 128 + d0; X[j][0] = *(const v4u*)pr; X[j][1] = *(const v4u*)(pr + 8); } }
#define GP_REDUCE(X, which) { float ax[16]; \
            _Pragma("unroll") for (int i = 0; i < 16; ++i) ax[i] = 0.f; \
            _Pragma("unroll") for (int j = 0; j < 5; ++j) { const float m = msk[j]; const float* cw = cwb + j * 1536 + (which) * 512; \
                _Pragma("unroll") for (int hc = 0; hc < 2; ++hc) { const v4u x = X[j][hc]; const f32x4 w0 = *(const f32x4*)(cw + 8 * hc), w1 = *(const f32x4*)(cw + 8 * hc + 4); \
                    ax[8 * hc + 0] += m * bflo(x.x) * w0.x; ax[8 * hc + 1] += m * bfhi(x.x) * w0.y; ax[8 * hc + 2] += m * bflo(x.y) * w0.z; ax[8 * hc + 3] += m * bfhi(x.y) * w0.w; \
                    ax[8 * hc + 4] += m * bflo(x.z) * w1.x; ax[8 * hc + 5] += m * bfhi(x.z) * w1.y; ax[8 * hc + 6] += m * bflo(x.w) * w1.z; ax[8 * hc + 7] += m * bfhi(x.w) * w1.w; } } \
            float ss = 0.f; \
            _Pragma("unroll") for (int i = 0; i < 16; ++i) { ax[i] = siluf(ax[i]); ss += ax[i] * ax[i]; } \
            ss += lane_read(ss, lane ^ 1); ss += lane_read(ss, lane ^ 2); ss += lane_read(ss, lane ^ 4); \
            const float sc = (which) == 0 ? 0.08838834764831845f * __builtin_amdgcn_rsqf(ss + 1e-6f) : ((which) == 1 ? __builtin_amdgcn_rsqf(ss + 1e-6f) : 1.0f); \
            _Pragma("unroll") for (int i = 0; i < 16; ++i) ax[i] *= sc; \
            if ((which) < 2) { _Pragma("unroll") for (int hc = 0; hc < 2; ++hc) { const int off = t * 256 + (((2 * sub + hc) ^ (t & 15)) << 4); \
                    v4u a; a.x = pk2(ax[8 * hc], ax[8 * hc + 1]); a.y = pk2(ax[8 * hc + 2], ax[8 * hc + 3]); a.z = pk2(ax[8 * hc + 4], ax[8 * hc + 5]); a.w = pk2(ax[8 * hc + 6], ax[8 * hc + 7]); \
                    *(LAS v4u*)(L + ((which) ? KB : QB) + off) = a; } } \
            if ((which) > 0) { _Pragma("unroll") for (int i = 0; i < 16; ++i) *(LAS bf16*)(L + ((which) == 1 ? KT : VT) + t64_off(d0 + i, t)) = (bf16)f2bf(ax[i]); } }
        GP_LOAD(xa, 0) GP_LOAD(xb, 1)
        GP_REDUCE(xa, 0)
        GP_LOAD(xa, 2)
        GP_REDUCE(xb, 1)
        GP_REDUCE(xa, 2)
#undef GP_LOAD
#undef GP_REDUCE
    }
    if (tid < 128) {
        const int d = tid >> 6, t = tid & 63; const bf16* pr = PROJ + (size_t)(ci.row0 + t) * NINP;
        const float a_raw = bf2f(pr[(d ? C_DAB : C_DAF) + h]), b_raw = bf2f(pr[(d ? C_DBB : C_DBF) + h]);
        const float la = -__expf(C.inp(I_ALOG)[(l * 2 + d) * 4 + h]) * softplusf(a_raw + C.inp(I_DTB)[(l * 2 + d) * 4 + h]);
        float ps = la;
#pragma unroll
        for (int off = 1; off < 64; off <<= 1) { const float v = lane_read(ps, t >= off ? t - off : t); if (t >= off) ps += v; }
        const float tot = lane_read(ps, 63), g = d ? (tot - ps + la) : ps;
        SG[d * 64 + t] = g; SG[128 + d * 64 + t] = sigmf(b_raw); SG[256 + d * 64 + t] = __expf(g); SG[384 + d * 64 + t] = __expf(tot - g);
        if (t == 0) SG[512 + d] = __expf(tot); }
    __syncthreads();
    {
        int lane = C.lane; asm volatile("" : "+v"(lane)); const int q = lane >> 4, c = lane & 15;
        const int mt = w & 3; const bool isq = w >= 4;
        f32x4 acc[4];
#pragma unroll
        for (int nt = 0; nt < 4; ++nt) acc[nt] = (f32x4){0.f, 0.f, 0.f, 0.f};
#pragma unroll
        for (int ks = 0; ks < 4; ++ks) { const bf16x8 a = frag128(L + (isq ? QB : KB), mt * 16, ks * 32, lane);
#pragma unroll
            for (int nt = 0; nt < 4; ++nt) acc[nt] = MFMA16(a, frag128(L + KB, nt * 16, ks * 32, lane), acc[nt]); }
#pragma unroll
        for (int nt = 0; nt < 4; ++nt)
#pragma unroll
            for (int r = 0; r < 4; ++r) { const int t = mt * 16 + 4 * q + r, s = nt * 16 + c; const float v = acc[nt][r];
                const float e0 = (s <= t) ? __expf(SG[t] - SG[s]) : 0.f, e1 = (s >= t) ? __expf(SG[64 + t] - SG[64 + s]) : 0.f;
                if (!isq) { ((LAS float*)(L + L0))[t * 64 + s] = (s < t) ? SG[128 + t] * e0 * v : 0.f; ((LAS float*)(L + L1))[(63 - t) * 64 + (63 - s)] = (s > t) ? SG[192 + t] * e1 * v : 0.f; }
                else { *(LAS bf16*)(L + QKM0 + t64_off(t, s)) = (bf16)f2bf(e0 * v); *(LAS bf16*)(L + QKM0 + 8192 + t64_off(t, s)) = (bf16)f2bf(e1 * v); } }
    }
    __syncthreads();
    gdn_inverse_blk(L, L0, TK0, SG, tid);
    __syncthreads();
    for (int d = 0; d < 2; ++d) {
        const int pid = (gc * 4 + h) * 2 + d;
        const LAS unsigned char* TKd = L + TK0 + d * 16384; const LAS unsigned char* TVd = TKd + 8192; const LAS unsigned char* QKMd = L + QKM0 + d * 8192;
        {
            int lane = C.lane; asm volatile("" : "+v"(lane)); const int q = lane >> 4, c = lane & 15;
            f32x4 aw[4], au[4];
#pragma unroll
            for (int nt = 0; nt < 4; ++nt) { aw[nt] = (f32x4){0.f, 0.f, 0.f, 0.f}; au[nt] = (f32x4){0.f, 0.f, 0.f, 0.f}; }
#pragma unroll
            for (int ks = 0; ks < 2; ++ks) { const bf16x8 ak = frag64(L + KT, w * 16, ks * 32, lane), av = frag64(L + VT, w * 16, ks * 32, lane);
#pragma unroll
                for (int nt = 0; nt < 4; ++nt) { aw[nt] = MFMA16(ak, frag64(TKd, nt * 16, ks * 32, lane), aw[nt]); au[nt] = MFMA16(av, frag64(TVd, nt * 16, ks * 32, lane), au[nt]); } }
#pragma unroll
            for (int nt = 0; nt < 4; ++nt)
#pragma unroll
                for (int r = 0; r < 4; ++r) { const int dd = w * 16 + 4 * q + r, i = nt * 16 + c;
                    *(LAS bf16*)(L + WT + t64_off(dd, i)) = (bf16)f2bf(aw[nt][r]); *(LAS bf16*)(L + UT + t64_off(dd, i)) = (bf16)f2bf(au[nt][r]); }
#pragma unroll
            for (int it = 0; it < 2; ++it) { const int idx = tid + it * NTHR, a = idx >> 3, ch = idx & 7, off = a * 128 + ((ch ^ ((a >> 1) & 7)) << 4);
                const v4u x = *(const LAS v4u*)(L + KT + off); const LAS float* cd = SG + 384 + d * 64 + ch * 8;
                v4u o; o.x = pk2(bflo(x.x) * cd[0], bfhi(x.x) * cd[1]); o.y = pk2(bflo(x.y) * cd[2], bfhi(x.y) * cd[3]); o.z = pk2(bflo(x.z) * cd[4], bfhi(x.z) * cd[5]); o.w = pk2(bflo(x.w) * cd[6], bfhi(x.w) * cd[7]);
                *(LAS v4u*)(L + KB + off) = o; }
        }
        __syncthreads();
        {
            int lane = C.lane; asm volatile("" : "+v"(lane)); const int q = lane >> 4, c = lane & 15;
            bf16x8 bq[4][2];
#pragma unroll
            for (int nt = 0; nt < 4; ++nt)
#pragma unroll
                for (int ks = 0; ks < 2; ++ks) bq[nt][ks] = frag64(QKMd, nt * 16, ks * 32, lane);
            f32x4 ao[4], al[4];
#pragma unroll
            for (int nt = 0; nt < 4; ++nt) { ao[nt] = (f32x4){0.f, 0.f, 0.f, 0.f}; al[nt] = (f32x4){0.f, 0.f, 0.f, 0.f}; }
#pragma unroll
            for (int ks = 0; ks < 2; ++ks) { const bf16x8 a1 = frag64(L + WT, w * 16, ks * 32, lane), a2 = frag64(L + UT, w * 16, ks * 32, lane);
#pragma unroll
                for (int nt = 0; nt < 4; ++nt) { ao[nt] = MFMA16(a1, bq[nt][ks], ao[nt]); al[nt] = MFMA16(a2, bq[nt][ks], al[nt]); } }
            bf16* goq = C.wsb(WS_GOQ) + (size_t)pid * 8192; bf16* ogdn = C.wsb(WS_OGDN) + ((size_t)d * M + ci.row0) * 512 + h * 128 + w * 16 + 4 * q;
#pragma unroll
            for (int nt = 0; nt < 4; ++nt) { const int i = nt * 16 + c; const float egi = SG[256 + d * 64 + i];
                const v2u qv = *(const LAS v2u*)(L + QB + t128_off(i, w * 16 + 4 * q));
                v2u o; o.x = pk2(egi * bflo(qv.x) - ao[nt][0], egi * bfhi(qv.x) - ao[nt][1]); o.y = pk2(egi * bflo(qv.y) - ao[nt][2], egi * bfhi(qv.y) - ao[nt][3]);
                *(v2u*)(goq + ((nt * 4 + (w >> 1)) * 64 + q * 16 + c) * 8 + 4 * (w & 1)) = o;
                v2u ol_; ol_.x = pk2(al[nt][0], al[nt][1]); ol_.y = pk2(al[nt][2], al[nt][3]); *(v2u*)(ogdn + (size_t)i * 512) = ol_; }
        }
#ifndef NO_RQ
        {
            int lane = C.lane; asm volatile("" : "+v"(lane)); const int q = lane >> 4, c = lane & 15;
            f32x4 ar[8], aq2[8];
#pragma unroll
            for (int nt = 0; nt < 8; ++nt) { ar[nt] = (f32x4){0.f, 0.f, 0.f, 0.f}; aq2[nt] = (f32x4){0.f, 0.f, 0.f, 0.f}; }
#pragma unroll
            for (int ks = 0; ks < 2; ++ks) { const bf16x8 a1 = frag64(L + WT, w * 16, ks * 32, lane), a2 = frag64(L + KB, w * 16, ks * 32, lane);
#pragma unroll
                for (int nt = 0; nt < 8; ++nt) { ar[nt] = MFMA16(a1, frag64(L + KB, nt * 16, ks * 32, lane), ar[nt]); aq2[nt] = MFMA16(a2, frag64(L + UT, nt * 16, ks * 32, lane), aq2[nt]); } }
            bf16* gr = C.wsb(WS_GR) + (size_t)pid * 16384; bf16* gq = C.wsb(WS_GQ) + (size_t)pid * 16384;
#pragma unroll
            for (int nt = 0; nt < 8; ++nt) { v2u o; o.x = pk2(-ar[nt][0], -ar[nt][1]); o.y = pk2(-ar[nt][2], -ar[nt][3]);
                *(v2u*)(gr + ((nt * 4 + (w >> 1)) * 64 + q * 16 + c) * 8 + 4 * (w & 1)) = o;
                v2u p; p.x = pk2(aq2[nt][0], aq2[nt][1]); p.y = pk2(aq2[nt][2], aq2[nt][3]);
                *(v2u*)(gq + ((nt * 8 + w) * 64 + lane) * 4) = p; }
        }
#endif
        if (tid == 0) C.wsf(WS_GEGL)[pid] = SG[512 + d];
        __syncthreads();
    }
}

struct ScanQo { v2u qv[8]; v2u ol[4]; float egl; };
__device__ __forceinline__ void gl16(v4u& d, const void* p) { asm volatile("global_load_dwordx4 %0, %1, off" : "=v"(d) : "v"(p) : "memory"); }
__device__ __forceinline__ void gl8(v2u& d, const void* p) { asm volatile("global_load_dwordx2 %0, %1, off" : "=v"(d) : "v"(p) : "memory"); }
template <int IMM> __device__ __forceinline__ void gl8s(v2u& d, unsigned voff, const void* sbase) { asm volatile("global_load_dwordx2 %0, %1, %2 offset:%3" : "=v"(d) : "v"(voff), "s"(sbase), "i"(IMM) : "memory"); }
__device__ __forceinline__ void gl4(float& d, const void* p) { asm volatile("global_load_dword %0, %1, off" : "=v"(d) : "v"(p) : "memory"); }
__device__ __forceinline__ void gdn_scan_unit(Ctx& C, int l, int seq, int h, int d, bool dry) {
    LAS unsigned char* L = C.lds;
    const int tid = C.tid, lane = C.lane, w = C.wave, q = lane >> 4, c = lane & 15;
    const int lat = seq >= 16, nc = lat ? 32 : 4, gc0 = lat ? 64 + (seq - 16) * 32 : seq * 4;
    const unsigned char* GRb = (const unsigned char*)C.wsb(WS_GR); const unsigned char* GOQb = (const unsigned char*)C.wsb(WS_GOQ);
    const bf16* GQp = C.wsb(WS_GQ); const float* GEGL = C.wsf(WS_GEGL); bf16* OG = C.wsb(WS_OGDN);
    f32x4 acc[8];
#pragma unroll
    for (int mt = 0; mt < 8; ++mt) acc[mt] = (f32x4){0.f, 0.f, 0.f, 0.f};
    if (lat) { const float* sp = C.inp(I_SGDN) + ((((size_t)(seq - 16) * 2 + l) * 2 + d) * 4 + h) * 16384 + w * 16 + c;
#pragma unroll
        for (int mt = 0; mt < 8; ++mt)
#pragma unroll
            for (int r = 0; r < 4; ++r) acc[mt][r] = sp[(size_t)(mt * 16 + 4 * q + r) * 128]; }
    asm volatile("s_waitcnt vmcnt(0)" ::: "memory");
#define SC_GC(n) (gc0 + (d ? nc - 1 - ((n) < nc ? (n) : nc - 1) : ((n) < nc ? (n) : nc - 1)))
#define SC_DMA(n) { const int pid_ = (SC_GC(n) * 4 + h) * 2 + d; LAS unsigned char* Bn_ = L + ((n) % 3) * 49152 + w * 1024; _Pragma("unroll") for (int k = 0; k < 6; ++k) \
        __builtin_amdgcn_global_load_lds((const unsigned*)(k < 4 ? GRb + (size_t)pid_ * 32768 + (k * NTHR + tid) * 16 : GOQb + (size_t)pid_ * 16384 + ((k - 4) * NTHR + tid) * 16), (LAS unsigned*)(Bn_ + k * 8192), 16, 0, 0); }
#define SC_WAIT_QO(Q, N) asm volatile("s_waitcnt vmcnt(" #N ")" : "+v"(Q.qv[0]), "+v"(Q.qv[1]), "+v"(Q.qv[2]), "+v"(Q.qv[3]), "+v"(Q.qv[4]), "+v"(Q.qv[5]), "+v"(Q.qv[6]), "+v"(Q.qv[7]), \
        "+v"(Q.ol[0]), "+v"(Q.ol[1]), "+v"(Q.ol[2]), "+v"(Q.ol[3]), "+v"(Q.egl) :: "memory");
#define SC_LOAD_QO(Q, n) { const int gc_ = SC_GC(n), pid_ = (gc_ * 4 + h) * 2 + d; \
        { const unsigned vo_ = (unsigned)(((w * 8) * 64 + lane) * 8); const void* sb_ = (const void*)(GQp + (size_t)pid_ * 16384); asm volatile("s_nop 4" ::: "memory"); \
          gl8s<0>(Q.qv[0], vo_, sb_); gl8s<512>(Q.qv[1], vo_, sb_); gl8s<1024>(Q.qv[2], vo_, sb_); gl8s<1536>(Q.qv[3], vo_, sb_); gl8s<2048>(Q.qv[4], vo_, sb_); gl8s<2560>(Q.qv[5], vo_, sb_); gl8s<3072>(Q.qv[6], vo_, sb_); gl8s<3584>(Q.qv[7], vo_, sb_); } \
        const bf16* op_ = OG + ((size_t)d * M + gc_ * 64 + c) * 512 + h * 128 + w * 16 + 4 * q; \
        _Pragma("unroll") for (int nt = 0; nt < 4; ++nt) gl8(Q.ol[nt], op_ + (size_t)nt * 16 * 512); gl4(Q.egl, GEGL + pid_); }
#define SC_STEP(n, Q) { const int gc_s = SC_GC(n); const LAS unsigned char* B = L + ((n) % 3) * 49152; \
        bf16x8 sb[4]; \
        _Pragma("unroll") for (int ks = 0; ks < 4; ++ks) { v4u p_; p_.x = pk2(acc[2 * ks][0], acc[2 * ks][1]); p_.y = pk2(acc[2 * ks][2], acc[2 * ks][3]); p_.z = pk2(acc[2 * ks + 1][0], acc[2 * ks + 1][1]); p_.w = pk2(acc[2 * ks + 1][2], acc[2 * ks + 1][3]); sb[ks] = __builtin_bit_cast(bf16x8, p_); } \
        SC_WAIT_QO(Q, 33) \
        f32x4 oacc[4]; \
        _Pragma("unroll") for (int nt = 0; nt < 4; ++nt) { oacc[nt][0] = bflo(Q.ol[nt].x); oacc[nt][1] = bfhi(Q.ol[nt].x); oacc[nt][2] = bflo(Q.ol[nt].y); oacc[nt][3] = bfhi(Q.ol[nt].y); } \
        _Pragma("unroll") for (int mt = 0; mt < 8; ++mt) { const float e_ = Q.egl; acc[mt][0] = e_ * acc[mt][0] + bflo(Q.qv[mt].x); acc[mt][1] = e_ * acc[mt][1] + bfhi(Q.qv[mt].x); acc[mt][2] = e_ * acc[mt][2] + bflo(Q.qv[mt].y); acc[mt][3] = e_ * acc[mt][3] + bfhi(Q.qv[mt].y); } \
        SC_LOAD_QO(Q, (n) + 2) \
        SC_DMA((n) + 2) \
        bf16* op_s = OG + ((size_t)d * M + gc_s * 64 + c) * 512 + h * 128 + w * 16 + 4 * q; \
        { v2u ost_[4]; \
          _Pragma("unroll") for (int hb = 0; hb < 2; ++hb) { bf16x8 f_[8]; \
            _Pragma("unroll") for (int i_ = 0; i_ < 8; ++i_) f_[i_] = *(const LAS bf16x8*)(B + 32768 + ((hb * 8 + i_) * 64 + lane) * 16); \
            __builtin_amdgcn_sched_barrier(0); \
            _Pragma("unroll") for (int n2 = 0; n2 < 2; ++n2) { const int nt = hb * 2 + n2; f32x4 o_ = oacc[nt]; \
                _Pragma("unroll") for (int ks = 0; ks < 4; ++ks) o_ = MFMA16(sb[ks], f_[n2 * 4 + ks], o_); \
                if (dry) o_ = oacc[nt]; ost_[nt].x = pk2(o_[0], o_[1]); ost_[nt].y = pk2(o_[2], o_[3]); } \
            __builtin_amdgcn_sched_barrier(0); } \
          _Pragma("unroll") for (int nt = 0; nt < 4; ++nt) *(v2u*)(op_s + (size_t)nt * 16 * 512) = ost_[nt]; } \
        _Pragma("unroll") for (int hb = 0; hb < 4; ++hb) { bf16x8 f_[8]; \
          _Pragma("unroll") for (int i_ = 0; i_ < 8; ++i_) f_[i_] = *(const LAS bf16x8*)(B + ((hb * 8 + i_) * 64 + lane) * 16); \
          __builtin_amdgcn_sched_barrier(0); \
          _Pragma("unroll") for (int m2 = 0; m2 < 2; ++m2) { f32x4 a_ = acc[hb * 2 + m2]; \
              _Pragma("unroll") for (int ks = 0; ks < 4; ++ks) a_ = MFMA16(f_[m2 * 4 + ks], sb[ks], a_); \
              acc[hb * 2 + m2] = a_; } \
          __builtin_amdgcn_sched_barrier(0); } \
        asm volatile("s_waitcnt vmcnt(27) lgkmcnt(0)" ::: "memory"); __builtin_amdgcn_s_barrier(); asm volatile("" ::: "memory"); }
    ScanQo q0, q1;
    SC_LOAD_QO(q0, 0) SC_LOAD_QO(q1, 1) SC_DMA(0) SC_DMA(1)
    SC_WAIT_QO(q0, 0) SC_WAIT_QO(q1, 0)
    asm volatile("s_waitcnt vmcnt(0) lgkmcnt(0)" ::: "memory"); __builtin_amdgcn_s_barrier(); asm volatile("" ::: "memory");
#pragma unroll 1
    for (int cc = 0; cc < nc; cc += 2) { SC_STEP(cc, q0) SC_STEP(cc + 1, q1) }
#undef SC_GC
#undef SC_DMA
#undef SC_WAIT_QO
#undef SC_LOAD_QO
#undef SC_STEP
    asm volatile("s_waitcnt vmcnt(0) lgkmcnt(0)" ::: "memory");
    if (!lat && !dry) { float* sp = C.outp() + O_SGDN + ((((size_t)seq * 2 + l) * 2 + d) * 4 + h) * 16384 + w * 16 + c;
#pragma unroll
        for (int mt = 0; mt < 8; ++mt)
#pragma unroll
            for (int r = 0; r < 4; ++r) sp[(size_t)(mt * 16 + 4 * q + r) * 128] = acc[mt][r]; }
    __syncthreads();
}
__device__ __forceinline__ int t32_off(int row, int col) { return row * 64 + (((col >> 3) ^ ((row >> 2) & 3)) << 4) + (col & 7) * 2; }
__device__ __forceinline__ bf16x8 frag32(const LAS unsigned char* T, int r0, int lane) { const int r = lane & 15, q = lane >> 4; return *(const LAS bf16x8*)(T + (r0 + r) * 64 + ((q ^ ((r >> 2) & 3)) << 4)); }
constexpr int GL_BC = 0, GL_TOT = 16384, GL_VT = 16896, GL_T0 = 25088;
__device__ __forceinline__ void gla_gates(Ctx& C, int l, const ChunkInfo& ci, int h, const bf16* PROJ) {
    LAS float* BC = (LAS float*)(C.lds + GL_BC); LAS float* TOT = (LAS float*)(C.lds + GL_TOT);
    int lane = C.lane; asm volatile("" : "+v"(lane)); const int w = C.wave, t = lane;
    const bf16* pr = PROJ + (size_t)(ci.row0 + t) * NINP;
#pragma unroll
    for (int d = 0; d < 2; ++d) { float lr[16]; load16bf(pr + (d ? C_GLRB : C_GLRF), lr);
        const float* up = C.inp(I_GKUP) + (size_t)(l * 2 + d) * 16 * 128 + h * 32 + w * 4; const float* bias = C.inp(I_GKB) + (l * 2 + d) * 128 + h * 32 + w * 4;
#pragma unroll
        for (int e = 0; e < 4; ++e) { float z = bias[e];
#pragma unroll
            for (int r = 0; r < 16; ++r) z += lr[r] * up[r * 128 + e];
            const float lg = (fminf(z, 0.f) - __logf(1.0f + __expf(-fabsf(z)))) * (1.0f / 16.0f);
            float ps = lg;
#pragma unroll
            for (int off = 1; off < 64; off <<= 1) { const float v = lane_read(ps, t >= off ? t - off : t); if (t >= off) ps += v; }
            const float tot = lane_read(ps, 63);
            BC[(d * 64 + t) * 32 + w * 4 + e] = d ? (tot - ps + lg) : ps;
            if (t == 0) TOT[d * 32 + w * 4 + e] = tot; } }
}
__device__ __forceinline__ void gla_load_vt(Ctx& C, const ChunkInfo& ci, int h, const bf16* PROJ) {
    const int t = C.tid >> 3, e8 = (C.tid & 7) * 8; float v[8];
    { const v4u a = *(const v4u*)(PROJ + (size_t)(ci.row0 + t) * NINP + C_GV + h * 64 + e8); v[0] = bflo(a.x); v[1] = bfhi(a.x); v[2] = bflo(a.y); v[3] = bfhi(a.y); v[4] = bflo(a.z); v[5] = bfhi(a.z); v[6] = bflo(a.w); v[7] = bfhi(a.w); }
#pragma unroll
    for (int i = 0; i < 8; ++i) *(LAS bf16*)(C.lds + GL_VT + t64_off(e8 + i, t)) = (bf16)f2bf(v[i]);
}
__device__ __forceinline__ void gla_prep_item(Ctx& C, int l, int gc, int h) {
    const ChunkInfo ci = chunk_info(gc); const bf16* PROJ = C.wsb(WS_PROJ);
    LAS float* BC = (LAS float*)(C.lds + GL_BC); LAS float* TOT = (LAS float*)(C.lds + GL_TOT);
    LAS unsigned char* KHT = C.lds + GL_T0;
    const v2u kv = *(const v2u*)(PROJ + (size_t)(ci.row0 + (C.tid >> 3)) * NINP + C_GK + h * 32 + (C.tid & 7) * 4);
    gla_gates(C, l, ci, h, PROJ); gla_load_vt(C, ci, h, PROJ);
    __syncthreads();
    { const int t = C.tid >> 3, dk4 = (C.tid & 7) * 4;
      const float k4[4] = {bflo(kv.x), bfhi(kv.x), bflo(kv.y), bfhi(kv.y)};
#pragma unroll
      for (int d = 0; d < 2; ++d)
#pragma unroll
          for (int e = 0; e < 4; ++e) *(LAS bf16*)(KHT + d * 4096 + t64_off(dk4 + e, t)) = (bf16)f2bf(k4[e] * __expf(TOT[d * 32 + dk4 + e] - BC[(d * 64 + t) * 32 + dk4 + e])); }
    __syncthreads();
    { int lane = C.lane; asm volatile("" : "+v"(lane)); const int q = lane >> 4, c = lane & 15, w = C.wave, d = w >> 2, mt = (w >> 1) & 1, nt0 = (w & 1) * 2;
      const int pid = (gc * 4 + h) * 2 + d; float* ds = C.wsf(WS_GLADS) + (size_t)pid * 2048;
      f32x4 acc[2] = {{0.f, 0.f, 0.f, 0.f}, {0.f, 0.f, 0.f, 0.f}};
#pragma unroll
      for (int ks = 0; ks < 2; ++ks) { const bf16x8 a = frag64(KHT + d * 4096, mt * 16, ks * 32, lane);
#pragma unroll
          for (int n = 0; n < 2; ++n) acc[n] = MFMA16(a, frag64(C.lds + GL_VT, (nt0 + n) * 16, ks * 32, lane), acc[n]); }
#pragma unroll
      for (int n = 0; n < 2; ++n)
#pragma unroll
          for (int r = 0; r < 4; ++r) ds[(mt * 16 + 4 * q + r) * 64 + (nt0 + n) * 16 + c] = acc[n][r];
      if (C.tid < 64) { const int dd = C.tid >> 5, dk = C.tid & 31; C.wsf(WS_GLADV)[((gc * 4 + h) * 2 + dd) * 32 + dk] = __expf(TOT[dd * 32 + dk]); } }
    __syncthreads();
}
struct S5Par { double lbr, lbi; float bre[16], bim[16]; };
__device__ __forceinline__ void s5_setup(Ctx& C, int l, int d, int g, int p, S5Par& P) {
    const int gi = (l * 2 + d) * 16 + g;
    const double lre = (double)C.inp(I_LRE)[gi * 64 + p], lim = (double)C.inp(I_LIM)[gi * 64 + p];
    const double step = (double)__expf(C.inp(I_LSTEP)[gi]);
    const double a = lre * step, ang = lim * step;
    const double ea = 1.0 + a * (1.0 + a * (0.5 + a * (1.0 / 6 + a * (1.0 / 24 + a * (1.0 / 120 + a * (1.0 / 720 + a * (1.0 / 5040 + a * (1.0 / 40320 + a * (1.0 / 362880)))))))));
    const double TWO_PI = 6.283185307179586476925286766559, INV_TWO_PI = 0.15915494309189533576888376337251;
    const double kk = rint(ang * INV_TWO_PI); const double r = (ang - kk * TWO_PI) * 0.125, r2 = r * r;
    double sn = r * (1.0 + r2 * (-1.0 / 6 + r2 * (1.0 / 120 + r2 * (-1.0 / 5040 + r2 * (1.0 / 362880 + r2 * (-1.0 / 39916800 + r2 * (1.0 / 6227020800.0)))))));
    double cs = 1.0 + r2 * (-0.5 + r2 * (1.0 / 24 + r2 * (-1.0 / 720 + r2 * (1.0 / 40320 + r2 * (-1.0 / 3628800 + r2 * (1.0 / 479001600.0 + r2 * (-1.0 / 87178291200.0)))))));
#pragma unroll
    for (int n = 0; n < 3; ++n) { const double s2 = 2.0 * sn * cs, c2 = cs * cs - sn * sn; sn = s2; cs = c2; }
    P.lbr = ea * cs; P.lbi = ea * sn;
    const double nr = P.lbr - 1.0, ni = P.lbi, den = lre * lre + lim * lim;
    double rden = (double)__builtin_amdgcn_rcpf((float)den); rden = rden * (2.0 - den * rden); rden = rden * (2.0 - den * rden);
    const float cfr = (float)((nr * lre + ni * lim) * rden), cfi = (float)((ni * lre - nr * lim) * rden);
    const float* br = C.inp(I_BRE) + ((size_t)gi * 64 + p) * 16; const float* bi = C.inp(I_BIM) + ((size_t)gi * 64 + p) * 16;
#pragma unroll
    for (int ch = 0; ch < 16; ++ch) { P.bre[ch] = cfr * br[ch] - cfi * bi[ch]; P.bim[ch] = cfr * bi[ch] + cfi * br[ch]; }
}
constexpr int S5_BB = 0, S5_CB = 8192, S5_BUT = 12288, S5_HT = S5_BUT + 8 * 8448;
__device__ __forceinline__ void s5_write_bb(const S5Par& P, LAS unsigned char* BB, int p) {
    v4u z = {0u, 0u, 0u, 0u}; v4u r0, r1, i0, i1;
    r0.x = pk2(P.bre[0], P.bre[1]); r0.y = pk2(P.bre[2], P.bre[3]); r0.z = pk2(P.bre[4], P.bre[5]); r0.w = pk2(P.bre[6], P.bre[7]);
    r1.x = pk2(P.bre[8], P.bre[9]); r1.y = pk2(P.bre[10], P.bre[11]); r1.z = pk2(P.bre[12], P.bre[13]); r1.w = pk2(P.bre[14], P.bre[15]);
    i0.x = pk2(P.bim[0], P.bim[1]); i0.y = pk2(P.bim[2], P.bim[3]); i0.z = pk2(P.bim[4], P.bim[5]); i0.w = pk2(P.bim[6], P.bim[7]);
    i1.x = pk2(P.bim[8], P.bim[9]); i1.y = pk2(P.bim[10], P.bim[11]); i1.z = pk2(P.bim[12], P.bim[13]); i1.w = pk2(P.bim[14], P.bim[15]);
    LAS v4u* rr = (LAS v4u*)(BB + p * 64); rr[0] = r0; rr[1] = r1; rr[2] = z; rr[3] = z;
    LAS v4u* ri = (LAS v4u*)(BB + (64 + p) * 64); ri[0] = i0; ri[1] = i1; ri[2] = z; ri[3] = z;
}
__device__ __forceinline__ bf16x8 s5_load_uf(const bf16* PROJ, int gc, int g, int tb, int lane) {
    const int q = lane >> 4, c = lane & 15; bf16x8 uf = {0, 0, 0, 0, 0, 0, 0, 0};
    if (q < 2) uf = *(const bf16x8*)(PROJ + (size_t)(gc * 64 + tb + c) * NINP + C_SU + g * 16 + 8 * q);
    return uf;
}
__device__ __forceinline__ void s5_bu_quarter(bf16x8 uf, const LAS unsigned char* BB, LAS float* BUT, int lane) {
    const int q = lane >> 4, c = lane & 15;
    bf16x8 bf[8];
#pragma unroll
    for (int nt = 0; nt < 8; ++nt) bf[nt] = *(const LAS bf16x8*)(BB + (nt * 16 + c) * 64 + q * 16);
#pragma unroll
    for (int nt = 0; nt < 8; ++nt) { f32x4 acc = {0.f, 0.f, 0.f, 0.f}; acc = MFMA16(bf[nt], uf, acc);
        *(LAS f32x4*)(BUT + c * 132 + nt * 16 + 4 * q) = acc; }
    asm volatile("s_waitcnt lgkmcnt(0)" ::: "memory");
}
__device__ __forceinline__ void s5_prep_blk(Ctx& C, int l, int bi) {
    const int gd = bi & 31, g = gd >> 1, d = gd & 1, cg = bi >> 5, p = C.lane;
    LAS unsigned char* BB = C.lds + S5_BB; LAS float* BUT = (LAS float*)(C.lds + S5_BUT + C.wave * 8448);
    const bf16* PROJ = C.wsb(WS_PROJ); float* S5E = C.wsf(WS_S5E);
    S5Par P; s5_setup(C, l, d, g, p, P);
    if (C.wave == 0) s5_write_bb(P, BB, p);
    __syncthreads();
    const float lbr = (float)P.lbr, lbi = (float)P.lbi;
    bf16x8 ufr[2][4];
#pragma unroll
    for (int j = 0; j < 2; ++j)
#pragma unroll
        for (int qq = 0; qq < 4; ++qq) ufr[j][qq] = s5_load_uf(PROJ, cg * 16 + C.wave * 2 + j, g, d ? 48 - 16 * qq : 16 * qq, p);
#pragma unroll
    for (int j = 0; j < 2; ++j) { const int gc = cg * 16 + C.wave * 2 + j; const size_t item = (size_t)(gc * 16 + g) * 2 + d;
        float hr = 0.f, hi = 0.f;
#pragma unroll
        for (int qq = 0; qq < 4; ++qq) { const int tb = d ? 48 - 16 * qq : 16 * qq;
            s5_bu_quarter(ufr[j][qq], BB, BUT, p);
#pragma unroll
            for (int ii = 0; ii < 16; ++ii) { const int tl = d ? 15 - ii : ii; const float br = BUT[tl * 132 + p], bi2 = BUT[tl * 132 + 64 + p];
                const float nr = lbr * hr - lbi * hi + br, ni = lbr * hi + lbi * hr + bi2; hr = nr; hi = ni; }
            asm volatile("s_waitcnt lgkmcnt(0)" ::: "memory"); }
        S5E[item * 128 + p] = hr; S5E[item * 128 + 64 + p] = hi; }
    __syncthreads();
}
__device__ __forceinline__ void ph_prep(Ctx& C, int l) {
    for (int it = C.vb; it < 256; it += C.nb) gdn_prep_item(C, l, 64 + (it >> 2), it & 3);
    for (int it = C.vb; it < 512; it += C.nb) gla_prep_item(C, l, it >> 2, it & 3);
    for (int bi = C.vb; bi < 256; bi += C.nb) s5_prep_blk(C, l, bi);
}

__device__ __forceinline__ void gla_scan_unit(Ctx& C, int l, int seq, int h, int d) {
    const int tid = C.tid; const int lat = seq >= 16, nc = lat ? 32 : 4, gc0 = lat ? 64 + (seq - 16) * 32 : seq * 4;
    const int dk = tid >> 4, e0 = (tid & 15) * 4;
    float* GLASC = C.wsf(WS_GLASC); const float* GLADS = C.wsf(WS_GLADS); const float* GLADV = C.wsf(WS_GLADV);
    f32x4 s = {0.f, 0.f, 0.f, 0.f};
    if (lat) s = *(const f32x4*)(C.inp(I_SGLA) + (((((size_t)(seq - 16) * 2 + l) * 2 + d) * 4 + h) * 32 + dk) * 64 + e0);
    for (int c0 = 0; c0 < nc; c0 += 4) {
        float dv[4]; f32x4 ds[4];
#pragma unroll
        for (int k = 0; k < 4; ++k) { const int cc = c0 + k, gc = gc0 + (d ? nc - 1 - cc : cc), pid = (gc * 4 + h) * 2 + d; dv[k] = GLADV[pid * 32 + dk]; ds[k] = *(const f32x4*)(GLADS + (size_t)pid * 2048 + dk * 64 + e0); }
#pragma unroll
        for (int k = 0; k < 4; ++k) { const int cc = c0 + k, gc = gc0 + (d ? nc - 1 - cc : cc), pid = (gc * 4 + h) * 2 + d;
            *(f32x4*)(GLASC + (size_t)pid * 2048 + dk * 64 + e0) = s; s = s * dv[k] + ds[k]; } }
    if (!lat) *(f32x4*)(C.outp() + O_SGLA + (((((size_t)seq * 2 + l) * 2 + d) * 4 + h) * 32 + dk) * 64 + e0) = s;
}
__device__ __forceinline__ void s5_scan_unit(Ctx& C, int l, int unit) {
    const int d = unit & 1, g = (unit >> 1) & 15, seq = unit >> 5, p = C.lane;
    const int lat = seq >= 16, nc = lat ? 32 : 4, gc0 = lat ? 64 + (seq - 16) * 32 : seq * 4;
    const float* S5E = C.wsf(WS_S5E); float* S5HS = C.wsf(WS_S5HS);
    S5Par P; s5_setup(C, l, d, g, p, P);
    double pr = P.lbr, pi = P.lbi;
#pragma unroll
    for (int n = 0; n < 6; ++n) { const double r2 = pr * pr - pi * pi, i2 = 2.0 * pr * pi; pr = r2; pi = i2; }
    const float l64r = (float)pr, l64i = (float)pi;
    float hr = 0.f, hi = 0.f;
    if (lat) { const size_t o = ((((size_t)(seq - 16) * 2 + l) * 2 + d) * 16 + g) * 64 + p; hr = C.inp(I_S5RE)[o]; hi = C.inp(I_S5IM)[o]; }
    for (int c0 = 0; c0 < nc; c0 += 4) {
        float er[4], ei[4];
#pragma unroll
        for (int k = 0; k < 4; ++k) { const int cc = c0 + k, gc = gc0 + (d ? nc - 1 - cc : cc); const size_t item = (size_t)(gc * 16 + g) * 2 + d; er[k] = S5E[item * 128 + p]; ei[k] = S5E[item * 128 + 64 + p]; }
#pragma unroll
        for (int k = 0; k < 4; ++k) { const int cc = c0 + k, gc = gc0 + (d ? nc - 1 - cc : cc); const size_t item = (size_t)(gc * 16 + g) * 2 + d;
            S5HS[item * 128 + p] = hr; S5HS[item * 128 + 64 + p] = hi;
            const float nr = l64r * hr - l64i * hi + er[k], ni = l64r * hi + l64i * hr + ei[k]; hr = nr; hi = ni; } }
    if (!lat) { const size_t o = ((((size_t)seq * 2 + l) * 2 + d) * 16 + g) * 64 + p; C.outp()[O_S5RE + o] = hr; C.outp()[O_S5IM + o] = hi; }
}
__device__ __forceinline__ void gla_out_item(Ctx& C, int l, int gc, int h) {
    const ChunkInfo ci = chunk_info(gc); const bf16* PROJ = C.wsb(WS_PROJ);
    LAS float* BC = (LAS float*)(C.lds + GL_BC);
    LAS unsigned char* QT = C.lds + GL_T0;
    LAS unsigned char* KT = QT + 8192;
    LAS unsigned char* SCT = KT + 8192;
    LAS unsigned char* AM = SCT + 8192;
    v2u qv, kv; f32x4 scv[2];
    { const int t = C.tid >> 3, dk4 = (C.tid & 7) * 4; const bf16* pr = PROJ + (size_t)(ci.row0 + t) * NINP;
      qv = *(const v2u*)(pr + C_GQ + h * 32 + dk4); kv = *(const v2u*)(pr + C_GK + h * 32 + dk4);
      const int dk = C.tid >> 4, e4 = (C.tid & 15) * 4;
#pragma unroll
      for (int d = 0; d < 2; ++d) scv[d] = *(const f32x4*)(C.wsf(WS_GLASC) + (size_t)((gc * 4 + h) * 2 + d) * 2048 + dk * 64 + e4); }
    gla_gates(C, l, ci, h, PROJ); gla_load_vt(C, ci, h, PROJ);
    __syncthreads();
    { const int t = C.tid >> 3, dk4 = (C.tid & 7) * 4;
      const float q4[4] = {bflo(qv.x), bfhi(qv.x), bflo(qv.y), bfhi(qv.y)}, k4[4] = {bflo(kv.x), bfhi(kv.x), bflo(kv.y), bfhi(kv.y)};
#pragma unroll
      for (int d = 0; d < 2; ++d) { float eb[4];
#pragma unroll
          for (int e = 0; e < 4; ++e) eb[e] = BC[(d * 64 + t) * 32 + dk4 + e];
          v2u qo, ko; qo.x = pk2(q4[0] * 0.17677669529663687f * __expf(eb[0]), q4[1] * 0.17677669529663687f * __expf(eb[1])); qo.y = pk2(q4[2] * 0.17677669529663687f * __expf(eb[2]), q4[3] * 0.17677669529663687f * __expf(eb[3]));
          ko.x = pk2(k4[0] * __expf(-eb[0]), k4[1] * __expf(-eb[1])); ko.y = pk2(k4[2] * __expf(-eb[2]), k4[3] * __expf(-eb[3]));
          *(LAS v2u*)(QT + d * 4096 + t32_off(t, dk4)) = qo; *(LAS v2u*)(KT + d * 4096 + t32_off(t, dk4)) = ko; }
      const int dk = C.tid >> 4, e4 = (C.tid & 15) * 4;
#pragma unroll
      for (int d = 0; d < 2; ++d) { const f32x4 sv = scv[d];
          *(LAS bf16*)(SCT + d * 4096 + t32_off(e4, dk)) = (bf16)f2bf(sv.x); *(LAS bf16*)(SCT + d * 4096 + t32_off(e4 + 1, dk)) = (bf16)f2bf(sv.y);
          *(LAS bf16*)(SCT + d * 4096 + t32_off(e4 + 2, dk)) = (bf16)f2bf(sv.z); *(LAS bf16*)(SCT + d * 4096 + t32_off(e4 + 3, dk)) = (bf16)f2bf(sv.w); } }
    __syncthreads();
    { int lane = C.lane; asm volatile("" : "+v"(lane)); const int q = lane >> 4, c = lane & 15, w = C.wave, d = w >> 2, mt = w & 3;
      const bf16x8 a = frag32(QT + d * 4096, mt * 16, lane);
#pragma unroll
      for (int nt = 0; nt < 4; ++nt) { f32x4 acc = {0.f, 0.f, 0.f, 0.f}; acc = MFMA16(a, frag32(KT + d * 4096, nt * 16, lane), acc);
#pragma unroll
          for (int r = 0; r < 4; ++r) { const int t = mt * 16 + 4 * q + r, s_ = nt * 16 + c; const bool keep = d ? (s_ >= t) : (s_ <= t);
              *(LAS bf16*)(AM + d * 8192 + t64_off(t, s_)) = (bf16)f2bf(keep ? acc[r] : 0.f); } } }
    __syncthreads();
    { int lane = C.lane; asm volatile("" : "+v"(lane)); const int q = lane >> 4, c = lane & 15, w = C.wave, d = w >> 2, ntk = w & 3;
      float* og = C.wsf(WS_OGLA) + ((size_t)d * M + ci.row0 + ntk * 16 + c) * 256 + h * 64 + 4 * q;
      const bf16x8 bq = frag32(QT + d * 4096, ntk * 16, lane), b0 = frag64(AM + d * 8192, ntk * 16, 0, lane), b1 = frag64(AM + d * 8192, ntk * 16, 32, lane);
#pragma unroll
      for (int me = 0; me < 4; ++me) { f32x4 acc = {0.f, 0.f, 0.f, 0.f};
          acc = MFMA16(frag64(C.lds + GL_VT, me * 16, 0, lane), b0, acc); acc = MFMA16(frag64(C.lds + GL_VT, me * 16, 32, lane), b1, acc);
          acc = MFMA16(frag32(SCT + d * 4096, me * 16, lane), bq, acc);
          *(f32x4*)(og + me * 16) = acc; } }
    __syncthreads();
}
__device__ __forceinline__ int t256_off(int row, int col) { return row * 512 + (((col >> 3) ^ (row & 15)) << 4) + (col & 7) * 2; }
__device__ __forceinline__ void s5_out_blk(Ctx& C, int l, int bi) {
    const int gd = bi & 31, g = gd >> 1, d = gd & 1, cg = bi >> 5, p = C.lane, q = p >> 4, c = p & 15;
    LAS unsigned char* BB = C.lds + S5_BB; LAS unsigned char* CB = C.lds + S5_CB;
    LAS float* BUT = (LAS float*)(C.lds + S5_BUT + C.wave * 8448); LAS unsigned char* HT = C.lds + S5_HT + C.wave * 4096;
    const bf16* PROJ = C.wsb(WS_PROJ); const float* S5HS = C.wsf(WS_S5HS); float* YS5 = C.wsf(WS_YS5);
    const int gi = (l * 2 + d) * 16 + g;
    { const float* cre = C.inp(I_CRE) + (size_t)gi * 1024; const float* cim = C.inp(I_CIM) + (size_t)gi * 1024;
#pragma unroll
      for (int k = 0; k < 4; ++k) { const int idx = C.tid + k * NTHR, ch = idx >> 7, kk = idx & 127;
          *(LAS bf16*)(CB + t128_off(ch, kk)) = (bf16)f2bf(kk < 64 ? cre[ch * 64 + kk] : -cim[ch * 64 + kk - 64]); } }
    S5Par P; s5_setup(C, l, d, g, p, P);
    if (C.wave == 0) s5_write_bb(P, BB, p);
    __syncthreads();
    const float lbr = (float)P.lbr, lbi = (float)P.lbi;
    bf16x8 ufr[2][4]; float hs[2][2];
#pragma unroll
    for (int j = 0; j < 2; ++j) { const size_t item = (size_t)((cg * 16 + C.wave * 2 + j) * 16 + g) * 2 + d; hs[j][0] = S5HS[item * 128 + p]; hs[j][1] = S5HS[item * 128 + 64 + p];
#pragma unroll
        for (int qq = 0; qq < 4; ++qq) ufr[j][qq] = s5_load_uf(PROJ, cg * 16 + C.wave * 2 + j, g, d ? 48 - 16 * qq : 16 * qq, p); }
#pragma unroll
    for (int j = 0; j < 2; ++j) { const int gc = cg * 16 + C.wave * 2 + j;
        float hr = hs[j][0], hi = hs[j][1];
#pragma unroll
        for (int qq = 0; qq < 4; ++qq) { const int tb = d ? 48 - 16 * qq : 16 * qq;
            s5_bu_quarter(ufr[j][qq], BB, BUT, p);
#pragma unroll
            for (int ii = 0; ii < 16; ++ii) { const int tl = d ? 15 - ii : ii; const float br = BUT[tl * 132 + p], bi2 = BUT[tl * 132 + 64 + p];
                const float nr = lbr * hr - lbi * hi + br, ni = lbr * hi + lbi * hr + bi2; hr = nr; hi = ni;
                *(LAS bf16*)(HT + t128_off(tl, p)) = (bf16)f2bf(hr); *(LAS bf16*)(HT + t128_off(tl, 64 + p)) = (bf16)f2bf(hi); }
            asm volatile("s_waitcnt lgkmcnt(0)" ::: "memory");
            f32x4 acc = {0.f, 0.f, 0.f, 0.f};
#pragma unroll
            for (int ks = 0; ks < 4; ++ks) acc = MFMA16(frag128(HT, 0, ks * 32, p), frag128(CB, 0, ks * 32, p), acc);
#pragma unroll
            for (int r = 0; r < 4; ++r) YS5[((size_t)d * M + gc * 64 + tb + 4 * q + r) * 256 + g * 16 + c] = acc[r];
            asm volatile("s_waitcnt lgkmcnt(0)" ::: "memory"); } }
    __syncthreads();
}

__device__ __forceinline__ void sub_barrier(Ctx& C, unsigned* cnt, unsigned target) {
    asm volatile("s_waitcnt vmcnt(0)" ::: "memory");
    __syncthreads();
    if (C.tid == 0) {
        __builtin_amdgcn_fence(__ATOMIC_RELEASE, "agent"); asm volatile("s_waitcnt vmcnt(0)" ::: "memory");
        __hip_atomic_fetch_add(cnt, 1u, __ATOMIC_RELAXED, __HIP_MEMORY_SCOPE_AGENT);
        unsigned spins = 0;
        while (__hip_atomic_load(cnt, __ATOMIC_RELAXED, __HIP_MEMORY_SCOPE_AGENT) < target) { __builtin_amdgcn_s_sleep(4); if (++spins > (1u << 22)) break; }
        __builtin_amdgcn_fence(__ATOMIC_ACQUIRE, "agent"); asm volatile("s_waitcnt vmcnt(0)" ::: "memory");
    }
    __syncthreads();
}
__device__ __forceinline__ int wq_next(Ctx& C, unsigned* q) {
    volatile LAS int* slot = (volatile LAS int*)(C.lds + LDS_CTL_OFF + 64);
    __syncthreads();
    if (C.tid == 0) *slot = (int)__hip_atomic_fetch_add(q, 1u, __ATOMIC_RELAXED, __HIP_MEMORY_SCOPE_AGENT);
    __syncthreads();
    return *slot;
}
__device__ __forceinline__ void ph_scan(Ctx& C, int l, int mode) {
    if (C.nb < 64) return;
    const int NS = C.nb - 16;
    if (C.vb < 16) { gdn_scan_unit(C, l, 16 + (C.vb >> 3), (C.vb >> 1) & 3, C.vb & 1, false); return; }
    unsigned* ctl = (unsigned*)(C.ws + WS_SUBBAR) + l * 256;
#define WQ_CTX() Ctx Ci = C; { int t_ = C.tid; asm volatile("" : "+v"(t_)); Ci.tid = t_; Ci.lane = t_ & 63; }
#pragma unroll 1
    for (int it = wq_next(C, ctl + 64); it < 472; it = wq_next(C, ctl + 64)) { WQ_CTX();
        if (it < 256) gdn_prep_item(Ci, l, it >> 2, it & 3);
        else if (it < 400) { const int u = it - 256; gla_scan_unit(Ci, l, u >> 3, (u >> 1) & 3, u & 1); }
        else s5_scan_unit(Ci, l, (it - 400) * NWAVES + Ci.wave); }
    sub_barrier(C, ctl, (unsigned)NS);
#pragma unroll 1
    for (int it = wq_next(C, ctl + 128); it < 896; it = wq_next(C, ctl + 128)) { WQ_CTX();
        if (it < 128) { const int u = 16 + it; gdn_scan_unit(Ci, l, (u - 16) >> 3, (u >> 1) & 3, u & 1, false); }
        else if (it < 384) s5_out_blk(Ci, l, it - 128);
        else { const int g = it - 384; gla_out_item(Ci, l, g >> 2, g & 3); } }
#undef WQ_CTX
}

__device__ __forceinline__ void ph_post(Ctx& C, int l) {
    LAS unsigned char* Gb = C.lds;
    const int tid = C.tid, lane = C.lane, wave = C.wave;
    const bf16* PROJ = C.wsb(WS_PROJ); const float* YS5 = C.wsf(WS_YS5); const bf16* WGT = C.wsb(WS_WGLU); bf16* HNp = C.wsb(WS_HN); const bf16* OGD = C.wsb(WS_OGDN);
    const float* glanw = C.inp(I_GLANW); const float* gdnnw = C.inp(I_GDNNW); const float* s5d = C.inp(I_S5D); const float* wglu = C.inp(I_WGLU); const float* bglu = C.inp(I_BGLU);
    for (int tile = C.vb; tile < 256; tile += C.nb) {
        const int r0 = tile * 32;
        for (int pr = wave; pr < 128; pr += NWAVES) { const int row = r0 + (pr >> 2), h = pr & 3;
            const float o = C.wsf(WS_OGLA)[(size_t)row * 256 + h * 64 + lane] + C.wsf(WS_OGLA)[((size_t)M + row) * 256 + h * 64 + lane];
            const float rs = __builtin_amdgcn_rsqf(wave_sum(o * o) * (1.f / 64.f) + 1e-6f);
            const float gate = bf2f(C.wsb(WS_PROJ)[(size_t)row * NINP + C_GOG + h * 64 + lane]);
            C.wsb(WS_HN)[(size_t)row * D + h * 64 + lane] = (bf16)f2bf(o * rs * glanw[l * 64 + lane] * siluf(gate)); }
        for (int pr = wave; pr < 128; pr += NWAVES) { const int row = r0 + (pr >> 2), h = pr & 3;
            const unsigned a0 = *(const unsigned*)(OGD + (size_t)row * 512 + h * 128 + 2 * lane), a1 = *(const unsigned*)(OGD + ((size_t)M + row) * 512 + h * 128 + 2 * lane);
            const float o0 = bflo(a0) + bflo(a1), o1 = bfhi(a0) + bfhi(a1);
            const float rs = __builtin_amdgcn_rsqf(wave_sum(o0 * o0 + o1 * o1) * (1.f / 128.f) + 1e-6f);
            const unsigned gg = *(const unsigned*)(PROJ + (size_t)row * NINP + C_DOG + h * 128 + 2 * lane);
            *(unsigned*)(HNp + (size_t)row * D + 256 + h * 128 + 2 * lane) = pk2(o0 * rs * gdnnw[l * 128 + 2 * lane] * siluf(bflo(gg)), o1 * rs * gdnnw[l * 128 + 2 * lane + 1] * siluf(bfhi(gg))); }
        for (int idx = tid; idx < 32 * 256; idx += NTHR) { const int tk = idx >> 8, row = r0 + tk, cix = idx & 255;
            const float y = bf2f(PROJ[(size_t)row * NINP + C_SU + cix]) * s5d[l * 256 + cix] + YS5[(size_t)row * 256 + cix] + YS5[((size_t)M + row) * 256 + cix];
            const float in = 0.7978845608028654f * (y + 0.044715f * y * y * y);
            *(LAS bf16*)(Gb + t256_off(tk, cix)) = (bf16)f2bf(0.5f * y * (2.0f - 2.0f * __builtin_amdgcn_rcpf(1.0f + __expf(2.0f * in)))); }
        __syncthreads();
        { const int q = lane >> 4, c = lane & 15;
          f32x4 acc[2][2];
#pragma unroll
          for (int a = 0; a < 2; ++a)
#pragma unroll
              for (int m = 0; m < 2; ++m) acc[a][m] = (f32x4){0.f, 0.f, 0.f, 0.f};
          const bf16* wt = WGT + (size_t)(wave * 32 + c) * 256 + 8 * q;
#pragma unroll
          for (int ks = 0; ks < 8; ++ks) { const bf16x8 a0 = *(const bf16x8*)(wt + ks * 32), a1 = *(const bf16x8*)(wt + 16 * 256 + ks * 32);
              const bf16x8 b0 = *(const LAS bf16x8*)(Gb + c * 512 + (((4 * ks + q) ^ c) << 4)), b1 = *(const LAS bf16x8*)(Gb + (16 + c) * 512 + (((4 * ks + q) ^ c) << 4));
              acc[0][0] = MFMA16(a0, b0, acc[0][0]); acc[0][1] = MFMA16(a0, b1, acc[0][1]); acc[1][0] = MFMA16(a1, b0, acc[1][0]); acc[1][1] = MFMA16(a1, b1, acc[1][1]); }
#pragma unroll
          for (int a = 0; a < 2; ++a)
#pragma unroll
              for (int m = 0; m < 2; ++m) { const int n0 = wave * 32 + a * 16 + 4 * q, tk = m * 16 + c;
                  const v2u gv = *(const LAS v2u*)(Gb + t256_off(tk, n0)); const f32x4 bg = *(const f32x4*)(bglu + l * 256 + n0);
                  v2u o; o.x = pk2(bflo(gv.x) * sigmf(acc[a][m][0] + bg.x), bfhi(gv.x) * sigmf(acc[a][m][1] + bg.y)); o.y = pk2(bflo(gv.y) * sigmf(acc[a][m][2] + bg.z), bfhi(gv.y) * sigmf(acc[a][m][3] + bg.w));
                  *(v2u*)(HNp + (size_t)(r0 + tk) * D + 768 + n0) = o; } }
        __syncthreads();
    }
}
constexpr int REP_KIND = -1, REP_N = 1;
#ifndef PHASE_MASK
#define PHASE_MASK 0xffffffffu
#endif
constexpr int PH_PER_LAYER = 11, N_PHASES = 1 + 2 * PH_PER_LAYER + 1;
#define MKCTX() Ctx C; { int tid_ = threadIdx.x; asm volatile("" : "+v"(tid_)); int vbr_ = blockIdx.x; asm volatile("" : "+s"(vbr_)); \
    C.lds = (LAS unsigned char*)lds_raw; C.tid = tid_; C.lane = tid_ & 63; C.wave = __builtin_amdgcn_readfirstlane(tid_ >> 6); \
    C.nb = gridDim.x; C.vb_raw = vbr_; C.vb = (C.nb % 8 == 0) ? (vbr_ % 8) * (C.nb / 8) + vbr_ / 8 : vbr_; \
    C.out = (float*)(GAS float*)C.ptab(34); C.ws = (unsigned char*)(GAS unsigned char*)C.ptab(35); }
#define IN(k) (lo <= (k) && (k) < hi)
#define SEAM(k) do { if ((k) + 1 < hi) xcd_barrier(bar); } while (0)
__device__ __forceinline__ float* ss_ptr(Ctx& C, int l, int inst) { return (float*)(C.ws + WS_SS) + (size_t)(l * 3 + inst) * M; }
template <int KIND>
__device__ __forceinline__ void gemm_res(Ctx& C, int l) {
    constexpr int j = KIND == 13; constexpr int KF = KIND == 10 ? D : FF; const bool first = (l == 0 && KIND == 3);
    const float* xb0 = C.outp(); const float* xb1 = xb0 + (size_t)MCTX * D;
    pg8::Gemm g{KIND == 10 ? C.wsb(WS_HN) : C.wsb(WS_H), KIND == 10 ? C.wsb(WS_WOUT) : C.wsb(WS_WD) + (size_t)j * D * FF, M, D, KF, KF}; pg8::StaticOrder S; S.init(M, D, C.nb, C.vb_raw, 1, 128);
    constexpr int gi = KIND == 3 ? 2 : (KIND == 10 ? 5 : 8);
    const int nl = KIND == 13 ? l + 1 : l, ninst = KIND == 3 ? 1 : (KIND == 10 ? 2 : 0); const bool has_next = nl < 2;
    pg8::EpiRes<true> E{first ? C.inp(I_XP) : xb0, first ? C.inp(I_XS) : xb1, C.outp(), KIND == 10 ? C.wsb(WS_HN2) : C.wsb(WS_HN), has_next ? ss_ptr(C, nl, ninst) : nullptr,
                  has_next ? C.wsf(WS_CW) + (size_t)(nl * 3 + ninst) * 3 * D : nullptr, C.wsf(WS_MOD) + (size_t)l * 3 * 9216 + gi * D, KIND == 10 ? 1.0f : 0.5f};
    pg8::gemm_phase<pg8::EpiRes<true>, pg8::StaticOrder, true, true, true>(C.lds, g, S, E, C.tid);
}
template <class Sched>
__device__ __forceinline__ const LAS float* fill_epi_lds(Ctx& C, const Sched& S, const float* SS, const float* bias, int ncols) {
    LAS float* EP = (LAS float*)(C.lds + 131072);
    for (int i = 0; i < 8; ++i) { pg8::Unit u; if (!S.next(i, u)) break;
        const int cid = u.pm < 16 ? 0 : 1 + ((u.pm - 16) >> 3), t = C.tid;
        EP[i * 512 + t] = t < 256 ? 1.0f / sqrtf(SS[u.pm * 256 + t] * (1.f / D) + 1e-6f) : bias[(size_t)cid * ncols + u.pn * 256 + (t - 256)]; }
    __syncthreads();
    return EP;
}
__device__ __forceinline__ void gemm_gu(Ctx& C, int l, int j) {
    pg8::Gemm g{j ? C.wsb(WS_HN2) : C.wsb(WS_HN), C.wsb(WS_WGU) + (size_t)j * NGU * D, M, NGU, D, D}; pg8::StaticOrder S; S.init(M, NGU, C.nb, C.vb_raw);
    pg8::EpiGU E{C.wsb(WS_H), fill_epi_lds(C, S, ss_ptr(C, l, j ? 2 : 0), C.wsf(WS_BGU) + (size_t)j * 3 * NGU, NGU)};
    pg8::gemm_phase<pg8::EpiGU, pg8::StaticOrder, true, true>(C.lds, g, S, E, C.tid);
}
__device__ __forceinline__ void gemm_inproj(Ctx& C, int l) {
    pg8::Gemm g{C.wsb(WS_HN), C.wsb(WS_WIN), M, NINP, D, D}; pg8::StaticOrder S; S.init(M, NINP, C.nb, C.vb_raw);
    pg8::EpiProj E{C.wsb(WS_PROJ), NINP, fill_epi_lds(C, S, ss_ptr(C, l, 1), C.wsf(WS_BIN), NINP)};
    pg8::gemm_phase<pg8::EpiProj, pg8::StaticOrder, true, true>(C.lds, g, S, E, C.tid);
}
__global__ void __launch_bounds__(NTHR, 2) fwd_kernel(Args a) {
    extern __shared__ __attribute__((aligned(16))) unsigned char lds_raw[];
    volatile LAS unsigned* MISC = (volatile LAS unsigned*)((LAS unsigned char*)lds_raw + LDS_CTL_OFF);
    if (threadIdx.x < 64) MISC[threadIdx.x] = 0u;
    if (threadIdx.x < 36) { const unsigned long long v = threadIdx.x < 34 ? (unsigned long long)a.in[threadIdx.x] : (threadIdx.x == 34 ? (unsigned long long)a.out : (unsigned long long)a.ws);
        MISC[64 + 2 * threadIdx.x] = (unsigned)v; MISC[64 + 2 * threadIdx.x + 1] = (unsigned)(v >> 32); }
    __syncthreads();
    XcdBarrier bar = xcd_barrier_post((unsigned*)(a.ws + WS_CTL) + CW_BAR, MISC + 8);
    const int lo = a.ph_lo, hi = a.ph_hi;
#define PHASE(k, kind, body) if (((PHASE_MASK >> ((kind) & 31)) & 1u) && IN(k)) { const int nrep_ = ((kind) == REP_KIND) ? REP_N : 1; _Pragma("unroll 1") for (int rep = 0; rep < nrep_; ++rep) { MKCTX(); body; } SEAM(k); }
    PHASE(0, 20, ph_mod(C); __syncthreads(); ph_wconv(C, 0))
#define LAYER(l) { constexpr int b = 1 + (l) * PH_PER_LAYER; \
        if ((l) > 0) { PHASE(b + 0, 0, ph_wconv(C, l)) } \
        PHASE(b + 1, 1, ph_bias(C, l); if ((l) == 0) ph_xb0(C)) \
        PHASE(b + 2, 2, gemm_gu(C, l, 0)) \
        PHASE(b + 3, 3, gemm_res<3>(C, l)) \
        PHASE(b + 4, 5, gemm_inproj(C, l)) \
        PHASE(b + 5, 6, ph_prep(C, l)) \
        PHASE(b + 6, 7, ph_scan(C, l, 0)) \
        PHASE(b + 7, 9, ph_post(C, l)) \
        PHASE(b + 8, 10, gemm_res<10>(C, l)) \
        PHASE(b + 9, 2, gemm_gu(C, l, 1)) \
        PHASE(b + 10, 3, gemm_res<13>(C, l)) }
    LAYER(0)
    LAYER(1)
    if (IN(N_PHASES - 1)) { MKCTX(); ph_final(C); if (REP_KIND == 100) for (int rep = 0; rep < REP_N; ++rep) xcd_barrier(bar); }
}

extern "C" void kernel_launch(void* const* d_in, const int* in_sizes, int n_in, void* d_out, int out_size, void* d_ws, size_t ws_size, hipStream_t stream) {
    static int grid = 0;
    if (grid == 0) {
        if (n_in != 34 || (size_t)out_size != O_END || ws_size < WS_END) { fprintf(stderr, "kernel_launch: unexpected shapes: n_in %d out %d ws %zu\n", n_in, out_size, ws_size); grid = -1; return; }
        int dev = 0, cus = 0, per_cu = 0;
        if (hipGetDevice(&dev) != hipSuccess || hipDeviceGetAttribute(&cus, hipDeviceAttributeMultiprocessorCount, dev) != hipSuccess) { grid = -1; return; }
        if (hipFuncSetAttribute((const void*)fwd_kernel, hipFuncAttributeMaxDynamicSharedMemorySize, LDS_BYTES) != hipSuccess) { fprintf(stderr, "kernel_launch: hipFuncSetAttribute failed\n"); grid = -1; return; }
        if (hipOccupancyMaxActiveBlocksPerMultiprocessor(&per_cu, (const void*)fwd_kernel, NTHR, LDS_BYTES) != hipSuccess || per_cu < 1) fprintf(stderr, "kernel_launch: occupancy query says %d\n", per_cu);
        (void)hipGetLastError();
        grid = cus;
    }
    if (grid < 0) return;
    (void)hipMemsetAsync((char*)d_ws + WS_CTL, 0, CTL_ZERO_BYTES, stream);
    Args a{};
    for (int i = 0; i < 34; ++i) a.in[i] = (const float*)d_in[i];
    a.out = (float*)d_out; a.ws = (unsigned char*)d_ws;
#ifndef ONE_LAUNCH
#define ONE_LAUNCH 1
#endif
#ifndef PROBE_PREFIX
#define PROBE_PREFIX 0
#endif
    if (PROBE_PREFIX > 0) { a.ph_lo = 0; a.ph_hi = PROBE_PREFIX; hipLaunchKernelGGL(fwd_kernel, dim3(grid), dim3(NTHR), LDS_BYTES, stream, a); (void)hipMemsetAsync((char*)d_ws + WS_CTL, 0, CTL_ZERO_BYTES, stream); }
    if (ONE_LAUNCH) { a.ph_lo = 0; a.ph_hi = N_PHASES; hipLaunchKernelGGL(fwd_kernel, dim3(grid), dim3(NTHR), LDS_BYTES, stream, a); }
    else for (int ph = 0; ph < N_PHASES; ++ph) { a.ph_lo = ph; a.ph_hi = ph + 1; hipLaunchKernelGGL(fwd_kernel, dim3(grid), dim3(NTHR), LDS_BYTES, stream, a); }
}
```

```cpp
#include <hip/hip_runtime.h>
#include <cstdio>
#include <cstdint>
#define LAS __attribute__((address_space(3)))
#define GAS __attribute__((address_space(1)))
namespace pg8 {
#define PG8_LAS __attribute__((address_space(3)))
typedef unsigned short bf16_t;
typedef short bf16x8 __attribute__((ext_vector_type(8)));
typedef float f32x4 __attribute__((ext_vector_type(4)));
typedef unsigned u32x4 __attribute__((ext_vector_type(4)));
constexpr int BM = 256, BK = 64, HALF = 128, HTB = HALF * BK * 2  , STAGE_BYTES = 8 * HTB, NXCD = 8, WGM = 8;

__host__ __device__ __forceinline__ int lds_byte(int r, int c) { const int st = (r >> 4) * 2 + (c >> 5), rr = r & 15, cc = c & 31, ob = rr * 64 + cc * 2; return st * 1024 + (ob ^ (((ob >> 9) & 1) << 5)); }
__host__ __device__ __forceinline__ void stage_rc(int b, int& R, int& C) { const int st = b / 1024, sb = b % 1024, swz = sb ^ (((sb >> 9) & 1) << 5); R = (st >> 1) * 16 + swz / 64; C = (st & 1) * 32 + (swz % 64) / 2; }
__host__ __device__ __forceinline__ int perm32(int rho) { const int n = rho >> 4, i = rho & 15; return 8 * (i >> 2) + 4 * n + (i & 3); }

struct Unit { int pm, pn, kh, idx; };
struct Gemm { const bf16_t* A; const bf16_t* Bt; int M, N, K, ld; };

struct StaticOrder {
    int nM, nN, nNr, nwg, G, c;
    __host__ __device__ void init(int M, int N, int G_, int c_, int ksplit = 1, int bn = BM) { nM = M / BM; nNr = N / bn; nN = nNr * ksplit; nwg = nM * nN; G = G_; c = c_; }
    __host__ __device__ bool next(int i, Unit& u) const {
        const long L = (long)i * G + c; if (L >= nwg) return false;
        int wgid = (int)L; { const int q = nwg / NXCD, r = nwg % NXCD, xcd = wgid % NXCD, off = wgid / NXCD; wgid = (xcd < r ? xcd * (q + 1) : r * (q + 1) + (xcd - r) * q) + off; }
        const int nig = WGM * nN, gid = wgid / nig, fm = gid * WGM, gsz = (nM - fm) < WGM ? (nM - fm) : WGM;
        u.pm = fm + ((wgid % nig) % gsz); const int pnr = (wgid % nig) / gsz; u.pn = pnr % nNr; u.kh = pnr / nNr; u.idx = i; return true;
    }
    __device__ __forceinline__ void a_ready(const Unit&) const {}
    __device__ __forceinline__ void done(const Unit&) const {}
};

__device__ __forceinline__ unsigned cvt_pk_bf16(float lo, float hi) { unsigned r; asm volatile("v_cvt_pk_bf16_f32 %0, %1, %2" : "=v"(r) : "v"(lo), "v"(hi)); return r; }
typedef float f32x2 __attribute__((ext_vector_type(2)));
template <class Epi, class Sched, bool ALIGN_EPI = false, bool SP2 = false, bool NB1 = false>
__device__ __forceinline__ void gemm_phase(PG8_LAS unsigned char* lds, const Gemm g, const Sched& S, const Epi& E, const int tid) {
    const int wid = __builtin_amdgcn_readfirstlane(tid >> 6), lane = tid & 63, wr = wid >> 2, wc = wid & 3, fr = lane & 15, fq = lane >> 4;
    const int K = g.K, ld = g.ld, nt = K / BK;
    unsigned voffA[2], voffB[2];
#pragma unroll
    for (int i = 0; i < 2; ++i) { int R, C; stage_rc(tid * 16 + i * 8192, R, C); const int Rb = Epi::PERM ? ((R & ~31) + perm32(R & 31)) : R;
        voffA[i] = (unsigned)(R * ld + C) * 2u; voffB[i] = (unsigned)(Rb * ld + C) * 2u; }
    const size_t kstep = (size_t)(BK * 2);
    const size_t hstep = (size_t)HALF * ld * 2;
    const size_t tstep = 2 * hstep;
    const unsigned ldsw = (unsigned)wid * 1024u;
    const int aoff = lds_byte(wr * 64 + fr, fq * 8), boff = lds_byte(wc * 32 + fr, fq * 8);
#define PG8_SA(b, h) (((b) * 2 + (h)) * HTB)
#define PG8_SB(b, h) ((4 + (b) * 2 + (h)) * HTB)
#define PG8_STAGE(bufoff, gbase, voff) do { _Pragma("unroll") for (int _i = 0; _i < 2; ++_i) \
        __builtin_amdgcn_global_load_lds((const unsigned*)((const char*)(gbase) + (voff)[_i]), (PG8_LAS unsigned*)(lds + (bufoff) + ldsw + _i * 8192), 16, 0, 0); } while (0)
#define PG8_LDA(dst, b, h) do { _Pragma("unroll") for (int m = 0; m < 4; ++m) _Pragma("unroll") for (int k = 0; k < 2; ++k) dst[m][k] = *(const PG8_LAS bf16x8*)(lds + PG8_SA(b, h) + aoff + m * 2048 + k * 1024); } while (0)
#define PG8_LDB(dst, b, h) do { _Pragma("unroll") for (int n = 0; n < 2; ++n) _Pragma("unroll") for (int k = 0; k < 2; ++k) dst[n][k] = *(const PG8_LAS bf16x8*)(lds + PG8_SB(b, h) + boff + n * 2048 + k * 1024); } while (0)
#define PG8_MMA(ai, bj, At, Bt) do { __builtin_amdgcn_s_setprio(1); _Pragma("unroll") for (int m = 0; m < 4; ++m) _Pragma("unroll") for (int n = 0; n < 2; ++n) _Pragma("unroll") for (int k = 0; k < 2; ++k) \
        acc[ai][bj][m][n] = __builtin_amdgcn_mfma_f32_16x16x32_bf16(Bt[n][k], At[m][k], acc[ai][bj][m][n], 0, 0, 0); __builtin_amdgcn_s_setprio(0); } while (0)
#define PG8_WAIT_V(n) asm volatile("s_waitcnt vmcnt(" #n ")" ::: "memory")
#define PG8_WAIT_L(n) asm volatile("s_waitcnt lgkmcnt(" #n ")" ::: "memory")
#define PG8_BAR __builtin_amdgcn_s_barrier()
#define PG8_SCHED __builtin_amdgcn_sched_barrier(0)
    Unit cur, nxt; int ui = 0;
    if (!S.next(0, cur)) return;
    f32x4 acc[2][2][4][2];
#pragma unroll
    for (int a = 0; a < 2; ++a)
#pragma unroll
        for (int b = 0; b < 2; ++b)
#pragma unroll
            for (int m = 0; m < 4; ++m)
#pragma unroll
                for (int n = 0; n < 2; ++n) acc[a][b][m][n] = (f32x4){0.f, 0.f, 0.f, 0.f};
    bf16x8 At[4][2], B0[2][2], B1[2][2];
    const char* cA = (const char*)g.A + (size_t)cur.pm * tstep + (size_t)cur.kh * K * 2; const char* cB = (const char*)g.Bt + (size_t)cur.pn * (NB1 ? hstep : tstep) + (size_t)cur.kh * K * 2;
    S.a_ready(cur);
    if constexpr (SP2) {
        PG8_STAGE(PG8_SB(0, 0), cB, voffB); if constexpr (!NB1) PG8_STAGE(PG8_SB(0, 1), cB + hstep, voffB); PG8_STAGE(PG8_SA(0, 0), cA, voffA); PG8_STAGE(PG8_SA(0, 1), cA + hstep, voffA);
        if (wr == 1) PG8_BAR;
        PG8_WAIT_V(2); PG8_BAR;
        PG8_STAGE(PG8_SB(1, 0), cB + kstep, voffB); PG8_STAGE(PG8_SA(1, 0), cA + kstep, voffA); if constexpr (!NB1) PG8_STAGE(PG8_SB(1, 1), cB + hstep + kstep, voffB);
        if constexpr (NB1) PG8_WAIT_V(4); else PG8_WAIT_V(6);
        PG8_BAR;
    } else {
        PG8_STAGE(PG8_SB(0, 0), cB, voffB); PG8_STAGE(PG8_SA(0, 0), cA, voffA); PG8_STAGE(PG8_SB(0, 1), cB + hstep, voffB); PG8_STAGE(PG8_SA(0, 1), cA + hstep, voffA);
        if (wr == 1) PG8_BAR;
        PG8_WAIT_V(4); PG8_BAR;
        PG8_STAGE(PG8_SB(1, 0), cB + kstep, voffB); PG8_STAGE(PG8_SA(1, 0), cA + kstep, voffA); PG8_STAGE(PG8_SB(1, 1), cB + hstep + kstep, voffB);
        PG8_WAIT_V(6); PG8_BAR;
    }
    for (;;) {
        const bool has_next = S.next(ui + 1, nxt);
        const char* nA = has_next ? (const char*)g.A + (size_t)nxt.pm * tstep + (size_t)nxt.kh * K * 2 : cA; const char* nB = has_next ? (const char*)g.Bt + (size_t)nxt.pn * (NB1 ? hstep : tstep) + (size_t)nxt.kh * K * 2 : cB;
        for (int t = 0; t < nt; t += 2) {
            const bool last = (t == nt - 2);
            const char* a1 = cA + (size_t)(t + 1) * kstep;
            const char* a2 = last ? nA : cA + (size_t)(t + 2) * kstep; const char* b2 = last ? nB : cB + (size_t)(t + 2) * kstep;
            const char* a3 = a2 + kstep; const char* b3 = b2 + kstep;
            if (last && has_next) S.a_ready(nxt);
            if constexpr (SP2) {
            if constexpr (!NB1) {
            PG8_LDB(B0, 0, 0); PG8_LDB(B1, 0, 1); PG8_SCHED; PG8_LDA(At, 0, 0); PG8_STAGE(PG8_SA(1, 1), a1 + hstep, voffA);
            PG8_WAIT_V(8); PG8_WAIT_L(0); PG8_BAR; PG8_MMA(0, 0, At, B0); PG8_MMA(0, 1, At, B1); PG8_BAR; PG8_SCHED;
            PG8_LDA(At, 0, 1); PG8_STAGE(PG8_SB(0, 0), b2, voffB); PG8_STAGE(PG8_SB(0, 1), b2 + hstep, voffB); PG8_STAGE(PG8_SA(0, 0), a2, voffA);
            PG8_WAIT_V(8); PG8_WAIT_L(0); PG8_BAR; PG8_MMA(1, 0, At, B0); PG8_MMA(1, 1, At, B1); PG8_BAR; PG8_SCHED;
            PG8_LDB(B0, 1, 0); PG8_LDB(B1, 1, 1); PG8_SCHED; PG8_LDA(At, 1, 0); PG8_STAGE(PG8_SA(0, 1), a2 + hstep, voffA);
            PG8_WAIT_V(8); PG8_WAIT_L(0); PG8_BAR; PG8_MMA(0, 0, At, B0); PG8_MMA(0, 1, At, B1); PG8_BAR; PG8_SCHED;
            PG8_LDA(At, 1, 1); PG8_STAGE(PG8_SB(1, 0), b3, voffB); PG8_STAGE(PG8_SB(1, 1), b3 + hstep, voffB); PG8_STAGE(PG8_SA(1, 0), a3, voffA);
            PG8_WAIT_V(8); PG8_WAIT_L(0); PG8_BAR; PG8_MMA(1, 0, At, B0); PG8_MMA(1, 1, At, B1); PG8_BAR; PG8_SCHED;
            } else {
            PG8_LDB(B0, 0, 0); PG8_SCHED; PG8_LDA(At, 0, 0); PG8_STAGE(PG8_SA(1, 1), a1 + hstep, voffA);
            PG8_WAIT_V(6); PG8_WAIT_L(0); PG8_BAR; PG8_MMA(0, 0, At, B0); PG8_BAR; PG8_SCHED;
            PG8_LDA(At, 0, 1); PG8_STAGE(PG8_SB(0, 0), b2, voffB); PG8_STAGE(PG8_SA(0, 0), a2, voffA);
            PG8_WAIT_V(6); PG8_WAIT_L(0); PG8_BAR; PG8_MMA(1, 0, At, B0); PG8_BAR; PG8_SCHED;
            PG8_LDB(B0, 1, 0); PG8_SCHED; PG8_LDA(At, 1, 0); PG8_STAGE(PG8_SA(0, 1), a2 + hstep, voffA);
            PG8_WAIT_V(6); PG8_WAIT_L(0); PG8_BAR; PG8_MMA(0, 0, At, B0); PG8_BAR; PG8_SCHED;
            PG8_LDA(At, 1, 1); PG8_STAGE(PG8_SB(1, 0), b3, voffB); PG8_STAGE(PG8_SA(1, 0), a3, voffA);
            PG8_WAIT_V(6); PG8_WAIT_L(0); PG8_BAR; PG8_MMA(1, 0, At, B0); PG8_BAR; PG8_SCHED;
            }
            } else {
            PG8_LDB(B0, 0, 0); PG8_SCHED; PG8_LDA(At, 0, 0); PG8_STAGE(PG8_SA(1, 1), a1 + hstep, voffA);
            PG8_WAIT_L(8); PG8_BAR; PG8_WAIT_L(0); PG8_MMA(0, 0, At, B0); PG8_BAR; PG8_SCHED;
            PG8_LDB(B1, 0, 1); PG8_STAGE(PG8_SB(0, 0), b2, voffB);
            PG8_BAR; PG8_WAIT_L(0); PG8_MMA(0, 1, At, B1); PG8_BAR;
            PG8_LDA(At, 0, 1); PG8_STAGE(PG8_SA(0, 0), a2, voffA);
            PG8_BAR; PG8_WAIT_L(0); PG8_MMA(1, 0, At, B0); PG8_BAR; PG8_SCHED;
            PG8_STAGE(PG8_SB(0, 1), b2 + hstep, voffB);
            PG8_WAIT_V(6); PG8_BAR; PG8_MMA(1, 1, At, B1); PG8_BAR;
            PG8_LDB(B0, 1, 0); PG8_SCHED; PG8_LDA(At, 1, 0); PG8_STAGE(PG8_SA(0, 1), a2 + hstep, voffA);
            PG8_WAIT_L(8); PG8_BAR; PG8_WAIT_L(0); PG8_MMA(0, 0, At, B0); PG8_BAR; PG8_SCHED;
            PG8_LDB(B1, 1, 1); PG8_STAGE(PG8_SB(1, 0), b3, voffB);
            PG8_BAR; PG8_WAIT_L(0); PG8_MMA(0, 1, At, B1); PG8_BAR;
            PG8_LDA(At, 1, 1); PG8_STAGE(PG8_SA(1, 0), a3, voffA);
            PG8_BAR; PG8_WAIT_L(0); PG8_MMA(1, 0, At, B0); PG8_BAR; PG8_SCHED;
            PG8_STAGE(PG8_SB(1, 1), b3 + hstep, voffB);
            PG8_WAIT_V(6); PG8_BAR; PG8_MMA(1, 1, At, B1); PG8_BAR;
            }
        }
        if constexpr (ALIGN_EPI) { if (wr == 0) PG8_BAR; }
        if constexpr (!Epi::AFTER_DRAIN) { E(acc, cur, wr, wc, fr, fq); S.done(cur); }
        if (!has_next) break;
#pragma unroll
        for (int a = 0; a < 2; ++a)
#pragma unroll
            for (int b = 0; b < 2; ++b)
#pragma unroll
                for (int m = 0; m < 4; ++m)
#pragma unroll
                    for (int n = 0; n < 2; ++n) acc[a][b][m][n] = (f32x4){0.f, 0.f, 0.f, 0.f};
        cur = nxt; cA = nA; cB = nB; ++ui;
        if constexpr (ALIGN_EPI) { if (wr == 1) PG8_BAR; }
    }
    PG8_WAIT_V(0);
    if constexpr (!ALIGN_EPI) { if (wr == 0) PG8_BAR; }
    PG8_BAR;
    if constexpr (Epi::AFTER_DRAIN) { E.fused(acc, cur, wr, wc, fr, fq, lds, wid, lane); S.done(cur); }
#undef PG8_SA
#undef PG8_SB
#undef PG8_STAGE
#undef PG8_LDA
#undef PG8_LDB
#undef PG8_MMA
#undef PG8_WAIT_V
#undef PG8_WAIT_L
#undef PG8_BAR
#undef PG8_SCHED
}
}
#define XB_TMO      128
#define XB_XCNT(j)  (256  + 64 * (j))
#define XB_XSUB(j)  (1280 + 64 * (j))
#define XB_XGEN(j)  (2304 + 64 * (j))
#define XB_TOP      3328
#define XB_TOPGEN   3392
#define XCD_BAR_WORDS 3456
#define XB_SPIN_CAP (1u << 18)

__device__ __forceinline__ unsigned xb_ld(unsigned* p)              { return __hip_atomic_load(p, __ATOMIC_RELAXED, __HIP_MEMORY_SCOPE_AGENT); }
__device__ __forceinline__ unsigned xb_add(unsigned* p, unsigned v) { return __hip_atomic_fetch_add(p, v, __ATOMIC_RELAXED, __HIP_MEMORY_SCOPE_AGENT); }
__device__ __forceinline__ unsigned xb_xcc_id() { return (unsigned)__builtin_amdgcn_s_getreg((3 << 11) | 20) & 0xFu; }
#define XB_SPIN(cond, bar) do { unsigned _sp = 0; while (cond) { __builtin_amdgcn_s_sleep(1); \
    if ((++_sp & 255u) == 0u) { if (xb_ld(&(bar)[XB_TMO])) break; if (_sp > XB_SPIN_CAP) { atomicAdd(&(bar)[XB_TMO], 1u); break; } } } } while (0)

struct XcdBarrier {
    unsigned* bar; unsigned x;
    volatile LAS unsigned* st;
};

__device__ __forceinline__ XcdBarrier xcd_barrier_post(unsigned* bar, volatile LAS unsigned* st) {
    XcdBarrier b; b.bar = bar; b.x = xb_xcc_id(); b.st = st;
    if (threadIdx.x == 0) (void)xb_add(&bar[XB_XCNT(b.x)], 1u);
    return b;
}
__device__ __forceinline__ void xcd_barrier_complete(unsigned* bar, unsigned x, unsigned& nloc, unsigned& nx) {
    const unsigned G = gridDim.x * gridDim.y * gridDim.z;
    unsigned sum, cnt, mine, sp = 0u;
    for (;;) {
        sum = 0u; cnt = 0u; mine = 0u;
#pragma unroll
        for (unsigned j = 0; j < 16; ++j) { const unsigned c = xb_ld(&bar[XB_XCNT(j)]); sum += c; cnt += (c > 0u) ? 1u : 0u; mine = (j == x) ? c : mine; }
        if (sum == G) break;
        __builtin_amdgcn_s_sleep(1);
        if ((++sp & 255u) == 0u) { if (xb_ld(&bar[XB_TMO])) break; if (sp > XB_SPIN_CAP) { atomicAdd(&bar[XB_TMO], 1u); break; } }
    }
    nloc = mine > 0u ? mine : 1u; nx = cnt > 0u ? cnt : 1u;
}

__device__ __forceinline__ void xcd_barrier(const XcdBarrier& b) {
    asm volatile("s_waitcnt vmcnt(0)" ::: "memory");
    __syncthreads();
    if (threadIdx.x == 0) {
        unsigned* bar = b.bar;
        __builtin_amdgcn_s_waitcnt(0);
        unsigned nloc = b.st[0], nx = b.st[1];
        if (nloc == 0u) { xcd_barrier_complete(bar, b.x, nloc, nx); b.st[0] = nloc; b.st[1] = nx; }
        const unsigned old = xb_add(&bar[XB_XSUB(b.x)], 1u);
        const unsigned gen = old / nloc;
        if (old + 1u == (gen + 1u) * nloc) {
            __builtin_amdgcn_fence(__ATOMIC_RELEASE, "agent");
            asm volatile("s_waitcnt vmcnt(0)" ::: "memory");
            const unsigned og = xb_add(&bar[XB_TOP], 1u);
            const unsigned tg = og / nx;
            if (og + 1u == (tg + 1u) * nx) xb_add(&bar[XB_TOPGEN], 1u);
            else XB_SPIN(xb_ld(&bar[XB_TOPGEN]) == tg, bar);
            __builtin_amdgcn_fence(__ATOMIC_ACQUIRE, "agent");
            xb_add(&bar[XB_XGEN(b.x)], 1u);
            asm volatile("s_waitcnt vmcnt(0)" ::: "memory");
        } else {
            XB_SPIN(xb_ld(&bar[XB_XGEN(b.x)]) == gen, bar);
            __builtin_amdgcn_fence(__ATOMIC_ACQUIRE, "agent");
            asm volatile("s_waitcnt vmcnt(0)" ::: "memory");
        }
    }
    __syncthreads();
}
typedef unsigned short bf16;
typedef unsigned v4u __attribute__((ext_vector_type(4)));
typedef unsigned v2u __attribute__((ext_vector_type(2)));
typedef float f32x4 __attribute__((ext_vector_type(4)));
typedef float f32x2 __attribute__((ext_vector_type(2)));
constexpr int NWAVES = 8, NTHR = 512;
constexpr int D = 1024, FF = 2816, NGU = 2 * FF, NIN = 3120, NINP = 3328, M = 8192, MCTX = 4096;
constexpr int C_GQ = 0, C_GK = 128, C_GV = 256, C_GLRF = 512, C_GLRB = 528, C_GOG = 544, C_DQ = 800, C_DK = 1312, C_DV = 1824,
              C_DAF = 2336, C_DAB = 2340, C_DBF = 2344, C_DBB = 2348, C_DOG = 2352, C_SU = 2864;
constexpr size_t O_Y = 0, O_SGLA = (size_t)M * D, O_SGDN = O_SGLA + 524288, O_S5RE = O_SGDN + 4194304, O_S5IM = O_S5RE + 65536, O_END = O_S5IM + 65536;
constexpr size_t MiB = 1u << 20;
constexpr size_t WS_CTL = 0, CTL_ZERO_BYTES = 1 * MiB;
constexpr size_t WS_MOD = 1 * MiB;
constexpr size_t WS_WGU = 2 * MiB;
constexpr size_t WS_WD = 26 * MiB;
constexpr size_t WS_WIN = 37 * MiB;
constexpr size_t WS_WOUT = 44 * MiB;
constexpr size_t WS_HN = 46 * MiB;
constexpr size_t WS_PROJ = 62 * MiB;
constexpr size_t WS_H = 62 * MiB;
constexpr size_t WS_GR = 114 * MiB;
constexpr size_t WS_GQ = 146 * MiB;
constexpr size_t WS_GOQ = 178 * MiB;
constexpr size_t WS_OGDN = 194 * MiB;
constexpr size_t WS_HN2 = 210 * MiB;
constexpr size_t WS_OGLA = 226 * MiB;
constexpr size_t WS_YS5 = 242 * MiB;
constexpr size_t WS_GLADS = 258 * MiB;
constexpr size_t WS_GLASC = 266 * MiB;
constexpr size_t WS_GLADV = 274 * MiB;
constexpr size_t WS_S5E = 275 * MiB;
constexpr size_t WS_S5HS = 277 * MiB;
constexpr size_t WS_GEGL = 279 * MiB;
constexpr size_t WS_WGLU = 279 * MiB + 512 * 1024;
constexpr size_t WS_END = 280 * MiB;
constexpr int CW_BAR = 4096;
constexpr size_t WS_SUBBAR = 48 * 1024;
constexpr size_t WS_SS = 64 * 1024;
constexpr size_t WS_CW = WS_MOD + 256 * 1024;
constexpr size_t WS_BGU = 512 * 1024;
constexpr size_t WS_BIN = WS_BGU + 2 * 2 * 3 * 5632 * 4;
constexpr int LDS_BYTES = 152 * 1024;
constexpr int LDS_CTL_OFF = 150 * 1024;

#define RLX_AGENT __ATOMIC_RELAXED, __HIP_MEMORY_SCOPE_AGENT
#if defined(__HIP_DEVICE_COMPILE__)
#define ASSUME_GLOBAL(p) __builtin_assume(!__builtin_amdgcn_is_shared((const void*)(p)) && !__builtin_amdgcn_is_private((const void*)(p)))
#else
#define ASSUME_GLOBAL(p) ((void)0)
#endif
__device__ __forceinline__ unsigned f2bf(float f) { unsigned u = __builtin_bit_cast(unsigned, f); return (u + 0x7fffu + ((u >> 16) & 1u)) >> 16; }
__device__ __forceinline__ unsigned pk2(float lo, float hi) { return f2bf(lo) | (f2bf(hi) << 16); }
__device__ __forceinline__ unsigned pk2v(float lo, float hi) { unsigned r; asm volatile("v_cvt_pk_bf16_f32 %0, %1, %2" : "=v"(r) : "v"(lo), "v"(hi)); return r; }
__device__ __forceinline__ float bf2f(unsigned short h) { return __builtin_bit_cast(float, (unsigned)h << 16); }
__device__ __forceinline__ float bflo(unsigned u) { return __builtin_bit_cast(float, u << 16); }
__device__ __forceinline__ float bfhi(unsigned u) { return __builtin_bit_cast(float, u & 0xffff0000u); }
__device__ __forceinline__ float siluf(float x) { return x * __builtin_amdgcn_rcpf(1.0f + __expf(-x)); }
__device__ __forceinline__ float sigmf(float x) { return __builtin_amdgcn_rcpf(1.0f + __expf(-x)); }
__device__ __forceinline__ float softplusf(float x) { return fmaxf(x, 0.f) + __logf(1.0f + __expf(-fabsf(x))); }
__device__ __forceinline__ float wave_sum(float v) {
#pragma unroll
    for (int o = 1; o < 64; o <<= 1) v += __shfl_xor(v, o);
    return v;
}

struct Args { const float* in[34]; float* out; unsigned char* ws; int ph_lo, ph_hi; };
__device__ __forceinline__ float lane_read(float v, int src_lane) { return __builtin_bit_cast(float, __builtin_amdgcn_ds_bpermute(src_lane << 2, __builtin_bit_cast(int, v))); }
struct Ctx {
    LAS unsigned char* lds;
    int tid, lane, wave, vb, nb, vb_raw;
    unsigned char* ws; float* out;
    __device__ __forceinline__ unsigned long long ptab(int i) const { const volatile LAS unsigned* p = (const volatile LAS unsigned*)(lds + LDS_CTL_OFF + 256) + 2 * i;
        const unsigned lo = __builtin_amdgcn_readfirstlane(p[0]), hi = __builtin_amdgcn_readfirstlane(p[1]); return ((unsigned long long)hi << 32) | lo; }
    __device__ __forceinline__ const float* inp(int i) const { return (const float*)(GAS const float*)ptab(i); }
    __device__ __forceinline__ float* outp() const { return out; }
    __device__ __forceinline__ float* wsf(size_t off) const { return (float*)(ws + off); }
    __device__ __forceinline__ bf16* wsb(size_t off) const { return (bf16*)(ws + off); }
};
enum { I_XP = 0, I_XS, I_C, I_SGLA, I_SGDN, I_S5RE, I_S5IM, I_CCTX, I_WADA, I_BADA, I_NORMW, I_WG, I_WU, I_WDN, I_WIN, I_GKUP, I_GKB, I_GLANW, I_CONVW, I_ALOG, I_DTB, I_GDNNW,
       I_LRE, I_LIM, I_LSTEP, I_BRE, I_BIM, I_CRE, I_CIM, I_S5D, I_WGLU, I_BGLU, I_WOUT, I_FNW };

struct ChunkInfo { int row0, seq, c, nc, lat, clo, chi, gc0; };
__device__ __forceinline__ ChunkInfo chunk_info(int gc) {
    ChunkInfo ci; ci.row0 = gc * 64;
    if (gc < 64) { ci.seq = gc >> 2; ci.c = gc & 3; ci.nc = 4; ci.lat = 0; ci.clo = ci.seq * 256; ci.chi = ci.clo + 256; ci.gc0 = ci.seq * 4; }
    else { ci.seq = 16 + ((gc - 64) >> 5); ci.c = (gc - 64) & 31; ci.nc = 32; ci.lat = 1; ci.clo = ci.row0; ci.chi = ci.row0 + 64; ci.gc0 = 64 + (ci.seq - 16) * 32; }
    return ci;
}
__device__ __forceinline__ int row_cid(int row) { return row < MCTX ? 0 : 1 + ((row - MCTX) >> 11); }

__device__ __forceinline__ void load16bf(const bf16* p, float (&x)[16]) {
    const v4u a = *(const v4u*)p, b = *(const v4u*)(p + 8);
    x[0] = bflo(a.x); x[1] = bfhi(a.x); x[2] = bflo(a.y); x[3] = bfhi(a.y); x[4] = bflo(a.z); x[5] = bfhi(a.z); x[6] = bflo(a.w); x[7] = bfhi(a.w);
    x[8] = bflo(b.x); x[9] = bfhi(b.x); x[10] = bflo(b.y); x[11] = bfhi(b.y); x[12] = bflo(b.z); x[13] = bfhi(b.z); x[14] = bflo(b.w); x[15] = bfhi(b.w);
}
__device__ __forceinline__ void ph_mod(Ctx& C) {
    LAS float* scond = (LAS float*)C.lds;
    LAS float* red = scond + 3072;
    for (int i = C.tid; i < 3072; i += NTHR) { const int cid = i >> 10, k = i & 1023; const float v = cid == 0 ? C.inp(I_CCTX)[k] : C.inp(I_C)[(cid - 1) * 1024 + k]; scond[i] = siluf(v); }
    __syncthreads();
    const float* wada = C.inp(I_WADA); const float* bada = C.inp(I_BADA);
    for (int unit = C.vb; unit < 288; unit += C.nb) {
        const int l = unit / 144, cb = (unit % 144) * 64, col = cb + C.lane;
        const float* w = wada + (size_t)l * 1024 * 9216 + col;
        float a0 = 0.f, a1 = 0.f, a2 = 0.f; const int k0 = C.wave * 128;
#pragma unroll 32
        for (int k = k0; k < k0 + 128; ++k) { const float wv = w[(size_t)k * 9216]; a0 += scond[k] * wv; a1 += scond[1024 + k] * wv; a2 += scond[2048 + k] * wv; }
        red[(C.wave * 3 + 0) * 64 + C.lane] = a0; red[(C.wave * 3 + 1) * 64 + C.lane] = a1; red[(C.wave * 3 + 2) * 64 + C.lane] = a2;
        __syncthreads();
        if (C.tid < 192) { const int cid = C.tid >> 6, ln = C.tid & 63; float s = bada[l * 9216 + cb + ln];
#pragma unroll
            for (int w8 = 0; w8 < 8; ++w8) s += red[(w8 * 3 + cid) * 64 + ln];
            C.wsf(WS_MOD)[(l * 3 + cid) * 9216 + cb + ln] = s;
            const int chunk = cb >> 10; if (chunk % 3 == 1) { const int inst = chunk / 3, col = (cb & 1023) + ln; C.wsf(WS_CW)[((l * 3 + inst) * 3 + cid) * D + col] = C.inp(I_NORMW)[(l * 3 + inst) * D + col] * (1.f + s); } }
        __syncthreads();
    }
}

constexpr int I_G = 16 * 88, I_D = 44 * 32, I_IN = 16 * 104, I_O = 16 * 32, I_GL = 4 * 8;
constexpr int W_A = 0, W_B = 2 * I_G, W_DA = 4 * I_G, W_DB = W_DA + I_D, W_IN = W_DB + I_D, W_OUT = W_IN + I_IN, W_GLU = W_OUT + I_O, W_END = W_GLU + I_GL;
constexpr int WC_SHL = 73728;
__device__ __forceinline__ float* bgu_ptr(Ctx& C, int l, int j) { return (float*)(C.ws + WS_BGU) + (size_t)(l * 2 + j) * 3 * NGU; }
__device__ __forceinline__ float* bin_ptr(Ctx& C, int l) { return (float*)(C.ws + WS_BIN) + (size_t)l * 3 * NINP; }
#define WDECODE(it_) \
    const float* W; bf16* WT; float* bias = nullptr; int K, N, NPAD, mode = 0, inst = 0, nrows = 0, r = (it_); \
    if (r < 4 * I_G) { const int j = r / (2 * I_G), gu = (r / I_G) & 1; r %= I_G; W = C.inp(gu ? I_WU : I_WG) + (size_t)(l * 2 + j) * D * FF; WT = C.wsb(WS_WGU) + (size_t)j * NGU * D; K = D; N = FF; NPAD = FF; mode = 1 + gu; \
        bias = bgu_ptr(C, l, j); inst = j ? 2 : 0; nrows = NGU; } \
    else if (r < W_IN) { r -= 4 * I_G; const int j = r / I_D; r %= I_D; W = C.inp(I_WDN) + (size_t)(l * 2 + j) * FF * D; WT = C.wsb(WS_WD) + (size_t)j * D * FF; K = FF; N = D; NPAD = D; } \
    else if (r < W_OUT) { r -= W_IN; W = C.inp(I_WIN) + (size_t)l * D * NIN; WT = C.wsb(WS_WIN); K = D; N = NIN; NPAD = NINP; bias = bin_ptr(C, l); inst = 1; nrows = NINP; } \
    else if (r < W_GLU) { r -= W_OUT; W = C.inp(I_WOUT) + (size_t)l * D * D; WT = C.wsb(WS_WOUT); K = D; N = D; NPAD = D; } \
    else { r -= W_GLU; W = C.inp(I_WGLU) + (size_t)l * 65536; WT = C.wsb(WS_WGLU); K = 256; N = 256; NPAD = 256; } \
    const int nblk_ = NPAD / 32, k0 = 64 * (r / nblk_), n0 = 32 * (r % nblk_);
__device__ __forceinline__ void wconv_load(Ctx& C, int l, int it, f32x4 (&v)[8]) {
    WDECODE(it) (void)WT; (void)bias; (void)K; (void)mode; (void)inst; (void)nrows;
    const int r8 = C.lane >> 3, c4 = (C.lane & 7) * 4;
#pragma unroll
    for (int i = 0; i < 8; ++i) { const f32x4 z = {0.f, 0.f, 0.f, 0.f}; v[i] = (n0 + c4 < N) ? *(const f32x4*)(W + (size_t)(k0 + 8 * i + r8) * N + n0 + c4) : z; }
}
template <bool WB>
__device__ __forceinline__ void wconv_finish(Ctx& C, int l, int it, const f32x4 (&v)[8], LAS float* scr) {
    WDECODE(it) (void)W; (void)N;
    const int lane = C.lane;
    { const int r8 = lane >> 3, c4 = (lane & 7) * 4;
#pragma unroll
      for (int i = 0; i < 8; ++i) { LAS float* d = scr + (8 * i + r8) * 33 + c4; d[0] = v[i].x; d[1] = v[i].y; d[2] = v[i].z; d[3] = v[i].w; } }
    asm volatile("s_waitcnt lgkmcnt(0)" ::: "memory");
    const int c = lane & 7;
    float p[3][4];
#pragma unroll
    for (int j = 0; j < 4; ++j) { const int nn = (lane >> 3) + 8 * j; const LAS float* s = scr + (8 * c) * 33 + nn;
        float sv[8];
#pragma unroll
        for (int t = 0; t < 8; ++t) sv[t] = s[t * 33];
        v4u o; o.x = pk2(sv[0], sv[1]); o.y = pk2(sv[2], sv[3]); o.z = pk2(sv[4], sv[5]); o.w = pk2(sv[6], sv[7]);
        const int n = n0 + nn; const int row = mode == 0 ? n : ((n >> 7) << 8) + (n & 127) + (mode == 2 ? 128 : 0);
        *(v4u*)(WT + (size_t)row * K + k0 + 8 * c) = o;
        if (WB) {
#pragma unroll
            for (int cid = 0; cid < 3; ++cid) { const LAS float* sh = (const LAS float*)(C.lds + WC_SHL) + (inst * 3 + cid) * 1024 + k0 + 8 * c; const f32x4 h0 = *(const LAS f32x4*)sh, h1 = *(const LAS f32x4*)(sh + 4);
                p[cid][j] = (sv[0] * h0.x + sv[1] * h0.y) + (sv[2] * h0.z + sv[3] * h0.w) + (sv[4] * h1.x + sv[5] * h1.y) + (sv[6] * h1.z + sv[7] * h1.w); } } }
    if (WB && bias != nullptr) {
#pragma unroll
        for (int cid = 0; cid < 3; ++cid)
#pragma unroll
            for (int j = 0; j < 4; ++j) { float x = p[cid][j]; x += __shfl_xor(x, 1); x += __shfl_xor(x, 2); x += __shfl_xor(x, 4); p[cid][j] = x; }
        if (c < 4) { const int n = n0 + (lane >> 3) + 8 * c; const int row = mode == 0 ? n : ((n >> 7) << 8) + (n & 127) + (mode == 2 ? 128 : 0);
#pragma unroll
            for (int cid = 0; cid < 3; ++cid) { const float q = c == 0 ? p[cid][0] : (c == 1 ? p[cid][1] : (c == 2 ? p[cid][2] : p[cid][3])); atomicAdd(bias + (size_t)cid * nrows + row, q); } } }
    asm volatile("s_waitcnt lgkmcnt(0)" ::: "memory");
}
template <bool WB, int LO0, int HI0, int LO1 = 0, int HI1 = 0, int LO2 = 0, int HI2 = 0, int LO3 = 0, int HI3 = 0>
__device__ __forceinline__ void wconv_set(Ctx& C, int l, int rk, int nblk) {
    LAS float* scr = (LAS float*)(C.lds + C.wave * 8448);
    constexpr int N0 = HI0 - LO0, N1 = HI1 - LO1, N2 = HI2 - LO2, N3 = HI3 - LO3, NT = N0 + N1 + N2 + N3;
#define WSEL(v_) ((v_) < N0 ? LO0 + (v_) : ((v_) < N0 + N1 ? LO1 + ((v_) - N0) : ((v_) < N0 + N1 + N2 ? LO2 + ((v_) - N0 - N1) : LO3 + ((v_) - N0 - N1 - N2))))
    int v = rk * NWAVES + C.wave; const int stride = nblk * NWAVES;
    if (v >= NT) return;
    f32x4 a[8]; wconv_load(C, l, WSEL(v), a);
#pragma unroll 1
    for (;;) { const int vn = v + stride; const bool more = vn < NT;
        f32x4 bnx[8];
#pragma unroll
        for (int i = 0; i < 8; ++i) bnx[i] = a[i];
        if (more) wconv_load(C, l, WSEL(vn), bnx);
        wconv_finish<WB>(C, l, WSEL(v), a, scr);
        if (!more) break;
#pragma unroll
        for (int i = 0; i < 8; ++i) a[i] = bnx[i];
        v = vn; }
#undef WSEL
}
__device__ __forceinline__ void wconv_stage_shift(Ctx& C, int l) {
    const float* MOD = C.wsf(WS_MOD); LAS float* shl = (LAS float*)(C.lds + WC_SHL);
    for (int i = C.tid; i < 9 * 1024; i += NTHR) { const int ic = i >> 10, inst = ic / 3, cid = ic % 3, k = i & 1023; shl[i] = MOD[(l * 3 + cid) * 9216 + (inst * 3) * D + k]; }
    __syncthreads();
}
template <bool WB, int LO0, int HI0, int LO1 = 0, int HI1 = 0, int LO2 = 0, int HI2 = 0, int LO3 = 0, int HI3 = 0>
__device__ __forceinline__ void tail_fill(Ctx& C, int l, int nunits) {
    const int rem = nunits % C.nb; if (rem == 0 || C.vb_raw < rem) return;
    asm volatile("s_waitcnt vmcnt(0) lgkmcnt(0)" ::: "memory"); __syncthreads();
    if (WB) wconv_stage_shift(C, l);
    wconv_set<WB, LO0, HI0, LO1, HI1, LO2, HI2, LO3, HI3>(C, l, C.vb_raw - rem, C.nb - rem);
}

__device__ __forceinline__ void ph_bias(Ctx& C, int l, int part) {
    const int gw = C.vb * NWAVES + C.wave, NGW = C.nb * NWAVES, lane = C.lane;
    const float* MOD = C.wsf(WS_MOD);
    {
        const int inst = part == 0 ? 0 : (part == 1 ? 2 : 1), nrows = part < 2 ? NGU : NINP;
        const bf16* W = part < 2 ? C.wsb(WS_WGU) + (size_t)part * NGU * D : C.wsb(WS_WIN);
        float* out = part < 2 ? bgu_ptr(C, l, part) : bin_ptr(C, l);
        float sh[3][16];
#pragma unroll
        for (int cid = 0; cid < 3; ++cid)
#pragma unroll
            for (int k = 0; k < 4; ++k) { const f32x4 v = *(const f32x4*)(MOD + (l * 3 + cid) * 9216 + (inst * 3) * D + lane * 16 + 4 * k); sh[cid][4 * k] = v.x; sh[cid][4 * k + 1] = v.y; sh[cid][4 * k + 2] = v.z; sh[cid][4 * k + 3] = v.w; }
        for (int n = gw; n < nrows; n += NGW) { float w[16]; load16bf(W + (size_t)n * D + lane * 16, w);
            float a0 = 0.f, a1 = 0.f, a2 = 0.f;
#pragma unroll
            for (int k = 0; k < 16; ++k) { a0 += w[k] * sh[0][k]; a1 += w[k] * sh[1][k]; a2 += w[k] * sh[2][k]; }
            a0 = wave_sum(a0); a1 = wave_sum(a1); a2 = wave_sum(a2);
            if (lane == 0) { out[n] = a0; out[nrows + n] = a1; out[2 * nrows + n] = a2; } }
    }
}
__device__ __forceinline__ void ph_xb0(Ctx& C) {
    const int gw = C.vb * NWAVES + C.wave, NGW = C.nb * NWAVES;
    const float* x0 = C.inp(I_XP); const float* x1 = C.inp(I_XS); bf16* HN = C.wsb(WS_HN); float* SS = (float*)(C.ws + WS_SS); const float* CW = C.wsf(WS_CW);
    for (int m = gw; m < M; m += NGW) {
        const int cid = row_cid(m); const float* xr = m < MCTX ? x0 + (size_t)m * D : x1 + (size_t)(m - MCTX) * D; const float* cw = CW + cid * D;
        float ss = 0.f;
#pragma unroll
        for (int j = 0; j < 4; ++j) { const int c0 = C.lane * 4 + 256 * j; const f32x4 v = *(const f32x4*)(xr + c0), w4 = *(const f32x4*)(cw + c0);
            ss += (v.x * v.x + v.y * v.y) + (v.z * v.z + v.w * v.w);
            v2u o; o.x = pk2(v.x * w4.x, v.y * w4.y); o.y = pk2(v.z * w4.z, v.w * w4.w); *(v2u*)(HN + (size_t)m * D + c0) = o; }
        ss = wave_sum(ss); if (C.lane == 0) SS[m] = ss;
    }
}
struct FinalRows { v4u r[4][2]; float rstd[4]; f32x4 w[2][2]; };
__device__ __forceinline__ void ph_final_load(Ctx& C, FinalRows& F) {
    const int gw = C.vb * NWAVES + C.wave, NGW = C.nb * NWAVES;
    const bf16* X = C.wsb(WS_HN); const float* nw = C.inp(I_FNW);
#pragma unroll
    for (int j = 0; j < 2; ++j) { F.w[j][0] = *(const f32x4*)(nw + j * 512 + C.lane * 8); F.w[j][1] = *(const f32x4*)(nw + j * 512 + C.lane * 8 + 4); }
#pragma unroll
    for (int k = 0; k < 4; ++k) { const int m = gw + k * NGW; const int mc = m < M ? m : M - 1;
        F.r[k][0] = *(const v4u*)(X + (size_t)mc * D + C.lane * 8); F.r[k][1] = *(const v4u*)(X + (size_t)mc * D + 512 + C.lane * 8); }
#pragma unroll
    for (int k = 0; k < 4; ++k) { float ss = 0.f;
#pragma unroll
        for (int j = 0; j < 2; ++j) { const v4u x = F.r[k][j]; ss += (bflo(x.x) * bflo(x.x) + bfhi(x.x) * bfhi(x.x)) + (bflo(x.y) * bflo(x.y) + bfhi(x.y) * bfhi(x.y)) + (bflo(x.z) * bflo(x.z) + bfhi(x.z) * bfhi(x.z)) + (bflo(x.w) * bflo(x.w) + bfhi(x.w) * bfhi(x.w)); }
        F.rstd[k] = 1.0f / sqrtf(wave_sum(ss) * (1.f / D) + 1e-6f); }
}
__device__ __forceinline__ void ph_final_store(Ctx& C, const FinalRows& F) {
    const int gw = C.vb * NWAVES + C.wave, NGW = C.nb * NWAVES;
#pragma unroll
    for (int k = 0; k < 4; ++k) { const int m = gw + k * NGW; if (m >= M) continue;
        float* xr = C.outp() + (size_t)m * D; const float rs = F.rstd[k];
#pragma unroll
        for (int j = 0; j < 2; ++j) { const v4u x = F.r[k][j]; const int c0 = j * 512 + C.lane * 8; const f32x4 w0 = F.w[j][0], w1 = F.w[j][1];
            f32x4 o0, o1; o0.x = bflo(x.x) * rs * w0.x; o0.y = bfhi(x.x) * rs * w0.y; o0.z = bflo(x.y) * rs * w0.z; o0.w = bfhi(x.y) * rs * w0.w;
            o1.x = bflo(x.z) * rs * w1.x; o1.y = bfhi(x.z) * rs * w1.y; o1.z = bflo(x.w) * rs * w1.z; o1.w = bfhi(x.w) * rs * w1.w;
            *(f32x4*)(xr + c0) = o0; *(f32x4*)(xr + c0 + 4) = o1; } }
}

namespace pg8 {
struct EpiGU {
    static constexpr bool PERM = true, AFTER_DRAIN = false;
    bf16_t* Hout; const PG8_LAS float* ep;
    __device__ __forceinline__ void operator()(const f32x4 (&acc)[2][2][4][2], const Unit& u, int wr, int wc, int fr, int fq) const {
        const int hcol0 = u.pn * 128 + wc * 32 + 8 * fq;
        const PG8_LAS float* e = ep + u.idx * 512;
        f32x4 bg[2], bu[2];
#pragma unroll
        for (int n = 0; n < 2; ++n) { bg[n] = *(const PG8_LAS f32x4*)(e + 256 + wc * 32 + 8 * fq + 4 * n); bu[n] = *(const PG8_LAS f32x4*)(e + 256 + HALF + wc * 32 + 8 * fq + 4 * n); }
#pragma unroll
        for (int ai = 0; ai < 2; ++ai)
#pragma unroll
            for (int m = 0; m < 4; ++m) { const int rl = wr * 64 + fr + ai * HALF + m * 16; const float rs = e[rl]; bf16_t* rowp = Hout + (size_t)(u.pm * BM + rl) * FF + hcol0;
                const f32x4 g0 = acc[ai][0][m][0] * rs + bg[0], g1 = acc[ai][0][m][1] * rs + bg[1], u0 = acc[ai][1][m][0] * rs + bu[0], u1 = acc[ai][1][m][1] * rs + bu[1];
                u32x4 w; w.x = cvt_pk_bf16(siluf(g0[0]) * u0[0], siluf(g0[1]) * u0[1]); w.y = cvt_pk_bf16(siluf(g0[2]) * u0[2], siluf(g0[3]) * u0[3]);
                w.z = cvt_pk_bf16(siluf(g1[0]) * u1[0], siluf(g1[1]) * u1[1]); w.w = cvt_pk_bf16(siluf(g1[2]) * u1[2], siluf(g1[3]) * u1[3]);
                *(u32x4*)rowp = w; }
    }
};
template <bool NB1> struct EpiRes {
    static constexpr bool PERM = true, AFTER_DRAIN = false;
    const float* base0; const float* base1; bf16_t* X; bf16_t* Xo; bf16_t* XB; float* SS;        const float* cw; const float* gate; float scale; bool first;
    __device__ __forceinline__ void operator()(const f32x4 (&acc)[2][2][4][2], const Unit& u, int wr, int wc, int fr, int fq) const { if (first) run<true>(acc, u, wr, wc, fr, fq); else run<false>(acc, u, wr, wc, fr, fq); }
    template <bool FIRST>
    __device__ __forceinline__ void run(const f32x4 (&acc)[2][2][4][2], const Unit& u, int wr, int wc, int fr, int fq) const {
        static_assert(NB1, "256 x 128 units only");
        const int row0 = u.pm * BM + wr * 64 + fr, col0 = u.pn * HALF + wc * 32 + 8 * fq;
        const int cid = u.pm < 16 ? 0 : 1 + ((u.pm - 16) >> 3);
        f32x4 gv[2], cv[2];
#pragma unroll
        for (int n = 0; n < 2; ++n) { gv[n] = *(const f32x4*)(gate + cid * 9216 + col0 + n * 4) * scale; cv[n] = cw ? *(const f32x4*)(cw + cid * D + col0 + n * 4) : (f32x4){0.f, 0.f, 0.f, 0.f}; }
        f32x4 b0[8], b1[8];
#pragma unroll
        for (int k = 0; k < 8; ++k) { const int row = row0 + (k >> 2) * HALF + (k & 3) * 16;
            if (FIRST) { const float* bp = (row < MCTX ? base0 + (size_t)row * D : base1 + (size_t)(row - MCTX) * D) + col0; b0[k] = *(const f32x4*)bp; b1[k] = *(const f32x4*)(bp + 4); }
            else { const u32x4 bx = *(const u32x4*)(X + (size_t)row * D + col0); b0[k] = (f32x4){bflo(bx.x), bfhi(bx.x), bflo(bx.y), bfhi(bx.y)}; b1[k] = (f32x4){bflo(bx.z), bfhi(bx.z), bflo(bx.w), bfhi(bx.w)}; } }
        float ss[8];
#pragma unroll
        for (int k = 0; k < 8; ++k) { const int ai = k >> 2, m = k & 3, row = row0 + ai * HALF + m * 16;
            const f32x4 x0 = b0[k] + gv[0] * acc[ai][0][m][0], x1 = b1[k] + gv[1] * acc[ai][0][m][1];
            { u32x4 xo; xo.x = cvt_pk_bf16(x0[0], x0[1]); xo.y = cvt_pk_bf16(x0[2], x0[3]); xo.z = cvt_pk_bf16(x1[0], x1[1]); xo.w = cvt_pk_bf16(x1[2], x1[3]); *(u32x4*)(Xo + (size_t)row * D + col0) = xo; }
            ss[k] = ((x0[0] * x0[0] + x0[1] * x0[1]) + (x0[2] * x0[2] + x0[3] * x0[3])) + ((x1[0] * x1[0] + x1[1] * x1[1]) + (x1[2] * x1[2] + x1[3] * x1[3]));
            if (cw) { const f32x4 y0 = x0 * cv[0], y1 = x1 * cv[1];
                u32x4 o; o.x = cvt_pk_bf16(y0[0], y0[1]); o.y = cvt_pk_bf16(y0[2], y0[3]); o.z = cvt_pk_bf16(y1[0], y1[1]); o.w = cvt_pk_bf16(y1[2], y1[3]); *(u32x4*)(XB + (size_t)row * D + col0) = o; } }
        if (cw) {
#pragma unroll
            for (int k = 0; k < 8; ++k) ss[k] += __shfl_xor(ss[k], 16);
#pragma unroll
            for (int k = 0; k < 8; ++k) ss[k] += __shfl_xor(ss[k], 32);
            if (fq == 0) {
#pragma unroll
                for (int k = 0; k < 8; ++k) atomicAdd(SS + row0 + (k >> 2) * HALF + (k & 3) * 16, ss[k]); } }
    }
};
struct EpiProj {
    static constexpr bool PERM = true, AFTER_DRAIN = false;
    bf16_t* O; int ldc; const PG8_LAS float* ep;
    __device__ __forceinline__ void operator()(const f32x4 (&acc)[2][2][4][2], const Unit& u, int wr, int wc, int fr, int fq) const {
        const int col0 = u.pn * BM + wc * 32 + 8 * fq;
        const PG8_LAS float* e = ep + u.idx * 512;
        f32x4 b0[2], b1[2];
#pragma unroll
        for (int bj = 0; bj < 2; ++bj) { b0[bj] = *(const PG8_LAS f32x4*)(e + 256 + wc * 32 + 8 * fq + bj * HALF); b1[bj] = *(const PG8_LAS f32x4*)(e + 256 + wc * 32 + 8 * fq + bj * HALF + 4); }
#pragma unroll
        for (int ai = 0; ai < 2; ++ai)
#pragma unroll
            for (int m = 0; m < 4; ++m) { const int rl = wr * 64 + fr + ai * HALF + m * 16; const float rs = e[rl]; bf16_t* rowp = O + (size_t)(u.pm * BM + rl) * ldc + col0;
#pragma unroll
                for (int bj = 0; bj < 2; ++bj) { const f32x4 v0 = acc[ai][bj][m][0] * rs + b0[bj], v1 = acc[ai][bj][m][1] * rs + b1[bj];
                    u32x4 w; w.x = cvt_pk_bf16(v0[0], v0[1]); w.y = cvt_pk_bf16(v0[2], v0[3]); w.z = cvt_pk_bf16(v1[0], v1[1]); w.w = cvt_pk_bf16(v1[2], v1[3]);
                    *(u32x4*)(rowp + bj * HALF) = w; } }
    }
};
}

__device__ __forceinline__ void lds8bf(const LAS bf16* p, float (&x)[8]) {
    const v4u a = *(const LAS v4u*)p;
    x[0] = bflo(a.x); x[1] = bfhi(a.x); x[2] = bflo(a.y); x[3] = bfhi(a.y); x[4] = bflo(a.z); x[5] = bfhi(a.z); x[6] = bflo(a.w); x[7] = bfhi(a.w);
}

typedef short bf16x8 __attribute__((ext_vector_type(8)));
#define MFMA16(a, b, c) __builtin_amdgcn_mfma_f32_16x16x32_bf16((a), (b), (c), 0, 0, 0)
__device__ __forceinline__ int t128_off(int row, int col) { return row * 256 + (((col >> 3) ^ (row & 15)) << 4) + (col & 7) * 2; }
__device__ __forceinline__ int t64_off(int row, int col) { return row * 128 + (((col >> 3) ^ ((row >> 1) & 7)) << 4) + (col & 7) * 2; }
__device__ __forceinline__ int lo64(int lane, int ks) { const int r = lane & 15, q = lane >> 4; return r * 128 + (((4 * ks + q) ^ ((r >> 1) & 7)) << 4); }
__device__ __forceinline__ int lo128(int lane, int ks) { const int r = lane & 15, q = lane >> 4; return r * 256 + (((4 * ks + q) ^ r) << 4); }
__device__ __forceinline__ bf16x8 frag128(const LAS unsigned char* T, int r0, int k0, int lane) { return *(const LAS bf16x8*)(T + r0 * 256 + lo128(lane, k0 >> 5)); }
__device__ __forceinline__ bf16x8 frag64(const LAS unsigned char* T, int r0, int k0, int lane) { return *(const LAS bf16x8*)(T + r0 * 128 + lo64(lane, k0 >> 5)); }

__device__ __forceinline__ void gdn_inverse_blk(LAS unsigned char* Lb, int L0off, int TKoff, const LAS float* SG, int tid) {
    const int d = tid >> 8, tl = tid & 255, wl = __builtin_amdgcn_readfirstlane(tl >> 6), lane = tid & 63, q = lane >> 4, c = lane & 15;
    const LAS float* Lm = (const LAS float*)(Lb + L0off + d * 16384);
    LAS float* Tf = (LAS float*)(Lb + TKoff + d * 16384);
    {
        const LAS float* Ld = Lm + (wl * 16) * 64 + wl * 16; float x[16];
#pragma unroll
        for (int i = 0; i < 16; ++i) { float a = (i == c) ? 1.f : 0.f;
#pragma unroll
            for (int j = 0; j < i; ++j) a -= Ld[i * 64 + j] * x[j];
            x[i] = a; }
#pragma unroll
        for (int i = 0; i < 16; ++i) Tf[(wl * 16 + i) * 64 + wl * 16 + c] = x[i]; }
    __syncthreads();
#pragma unroll
    for (int dist = 1; dist < 4; ++dist) {
        if (wl + dist < 4) { const int j = wl, i = wl + dist;
            f32x4 P = {0.f, 0.f, 0.f, 0.f};
            for (int k = j; k < i; ++k) {
#pragma unroll
                for (int ks = 0; ks < 4; ++ks) P = __builtin_amdgcn_mfma_f32_16x16x4f32(Lm[(i * 16 + c) * 64 + k * 16 + 4 * ks + q], Tf[(k * 16 + 4 * ks + q) * 64 + j * 16 + c], P, 0, 0, 0); }
            f32x4 T = {0.f, 0.f, 0.f, 0.f};
#pragma unroll
            for (int ks = 0; ks < 4; ++ks) T = __builtin_amdgcn_mfma_f32_16x16x4f32(-Tf[(i * 16 + c) * 64 + i * 16 + 4 * q + ks], P[ks], T, 0, 0, 0);
#pragma unroll
            for (int r = 0; r < 4; ++r) Tf[(i * 16 + 4 * q + r) * 64 + j * 16 + c] = T[r]; }
        __syncthreads();
    }
    float vals[16];
#pragma unroll
    for (int k = 0; k < 16; ++k) { const int idx = tl + 256 * k, u = idx >> 6, v = idx & 63; vals[k] = ((v >> 4) <= (u >> 4)) ? Tf[u * 64 + v] : 0.f; }
    __syncthreads();
    LAS unsigned char* TK = Lb + TKoff + d * 16384; LAS unsigned char* TV = TK + 8192;
#pragma unroll
    for (int k = 0; k < 16; ++k) { const int idx = tl + 256 * k, u = idx >> 6, v = idx & 63, t = d ? 63 - u : u, sidx = d ? 63 - v : v;
        const float sv = SG[128 + d * 64 + sidx], sk = sv * SG[256 + d * 64 + sidx];
        *(LAS bf16*)(TK + t64_off(t, sidx)) = (bf16)f2bf(vals[k] * sk); *(LAS bf16*)(TV + t64_off(t, sidx)) = (bf16)f2bf(vals[k] * sv); }
}

__device__ __forceinline__ void gdn_prep_item(Ctx& C, int l, int gc, int h) {
    LAS unsigned char* L = C.lds;
    constexpr int QB = 0, KB = 16384, KT = 32768, VT = 49152, L0 = 65536, L1 = 81920, WT = 65536, UT = 81920, QKM0 = 98304, TK0 = 114688, SGO = 147456;
    LAS float* SG = (LAS float*)(L + SGO);
    const ChunkInfo ci = chunk_info(gc);
    int tid = C.tid; asm volatile("" : "+v"(tid));
    const int lane = tid & 63, w = C.wave, q = lane >> 4, c = lane & 15;
    const bf16* PROJ = C.wsb(WS_PROJ);
    {
        const int t = tid >> 3, sub = tid & 7, d0 = sub * 16, row = ci.row0 + t;
        const float* cwb = C.inp(I_CONVW) + (size_t)l * 5 * 1536 + h * 128 + d0;
        float msk[5]; int rcl[5];
#pragma unroll
        for (int j = 0; j < 5; ++j) { const int r = row + j - 2; msk[j] = (r >= ci.clo && r < ci.chi) ? 1.f : 0.f; rcl[j] = r < ci.clo ? ci.clo : (r >= ci.chi ? ci.chi - 1 : r); }
        v4u xa[5][2], xb[5][2];
#define GP_LOAD(X, which) { _Pragma("unroll") for (int j = 0; j < 5; ++j) { const bf16* pr = PROJ + (size_t)rcl[j] * NINP + C_DQ + (which) * 512 + h * 128 + d0; X[j][0] = *(const v4u*)pr; X[j][1] = *(const v4u*)(pr + 8); } }
#define GP_REDUCE(X, which) { float ax[16]; \
            _Pragma("unroll") for (int i = 0; i < 16; ++i) ax[i] = 0.f; \
            _Pragma("unroll") for (int j = 0; j < 5; ++j) { const float m = msk[j]; const float* cw = cwb + j * 1536 + (which) * 512; \
                _Pragma("unroll") for (int hc = 0; hc < 2; ++hc) { const v4u x = X[j][hc]; const f32x4 w0 = *(const f32x4*)(cw + 8 * hc), w1 = *(const f32x4*)(cw + 8 * hc + 4); \
                    ax[8 * hc + 0] += m * bflo(x.x) * w0.x; ax[8 * hc + 1] += m * bfhi(x.x) * w0.y; ax[8 * hc + 2] += m * bflo(x.y) * w0.z; ax[8 * hc + 3] += m * bfhi(x.y) * w0.w; \
                    ax[8 * hc + 4] += m * bflo(x.z) * w1.x; ax[8 * hc + 5] += m * bfhi(x.z) * w1.y; ax[8 * hc + 6] += m * bflo(x.w) * w1.z; ax[8 * hc + 7] += m * bfhi(x.w) * w1.w; } } \
            float ss = 0.f; \
            _Pragma("unroll") for (int i = 0; i < 16; ++i) { ax[i] = siluf(ax[i]); ss += ax[i] * ax[i]; } \
            ss += lane_read(ss, lane ^ 1); ss += lane_read(ss, lane ^ 2); ss += lane_read(ss, lane ^ 4); \
            const float sc = (which) == 0 ? 0.08838834764831845f * __builtin_amdgcn_rsqf(ss + 1e-6f) : ((which) == 1 ? __builtin_amdgcn_rsqf(ss + 1e-6f) : 1.0f); \
            _Pragma("unroll") for (int i = 0; i < 16; ++i) ax[i] *= sc; \
            if ((which) < 2) { _Pragma("unroll") for (int hc = 0; hc < 2; ++hc) { const int off = t * 256 + (((2 * sub + hc) ^ (t & 15)) << 4); \
                    v4u a; a.x = pk2(ax[8 * hc], ax[8 * hc + 1]); a.y = pk2(ax[8 * hc + 2], ax[8 * hc + 3]); a.z = pk2(ax[8 * hc + 4], ax[8 * hc + 5]); a.w = pk2(ax[8 * hc + 6], ax[8 * hc + 7]); \
                    *(LAS v4u*)(L + ((which) ? KB : QB) + off) = a; } } \
            if ((which) > 0) { _Pragma("unroll") for (int i = 0; i < 16; ++i) *(LAS bf16*)(L + ((which) == 1 ? KT : VT) + t64_off(d0 + i, t)) = (bf16)f2bf(ax[i]); } }
        GP_LOAD(xa, 0) GP_LOAD(xb, 1)
        GP_REDUCE(xa, 0)
        GP_LOAD(xa, 2)
        GP_REDUCE(xb, 1)
        GP_REDUCE(xa, 2)
#undef GP_LOAD
#undef GP_REDUCE
    }
    if (tid < 128) {
        const int d = tid >> 6, t = tid & 63; const bf16* pr = PROJ + (size_t)(ci.row0 + t) * NINP;
        const float a_raw = bf2f(pr[(d ? C_DAB : C_DAF) + h]), b_raw = bf2f(pr[(d ? C_DBB : C_DBF) + h]);
        const float la = -__expf(C.inp(I_ALOG)[(l * 2 + d) * 4 + h]) * softplusf(a_raw + C.inp(I_DTB)[(l * 2 + d) * 4 + h]);
        float ps = la;
#pragma unroll
        for (int off = 1; off < 64; off <<= 1) { const float v = lane_read(ps, t >= off ? t - off : t); if (t >= off) ps += v; }
        const float tot = lane_read(ps, 63), g = d ? (tot - ps + la) : ps;
        SG[d * 64 + t] = g; SG[128 + d * 64 + t] = sigmf(b_raw); SG[256 + d * 64 + t] = __expf(g); SG[384 + d * 64 + t] = __expf(tot - g);
        if (t == 0) SG[512 + d] = __expf(tot); }
    __syncthreads();
    {
        int lane = C.lane; asm volatile("" : "+v"(lane)); const int q = lane >> 4, c = lane & 15;
        const int mt = w & 3; const bool isq = w >= 4;
        f32x4 acc[4];
#pragma unroll
        for (int nt = 0; nt < 4; ++nt) acc[nt] = (f32x4){0.f, 0.f, 0.f, 0.f};
#pragma unroll
        for (int ks = 0; ks < 4; ++ks) { const bf16x8 a = frag128(L + (isq ? QB : KB), mt * 16, ks * 32, lane);
#pragma unroll
            for (int nt = 0; nt < 4; ++nt) acc[nt] = MFMA16(a, frag128(L + KB, nt * 16, ks * 32, lane), acc[nt]); }
        float g0t[4], g1t[4], b0t[4], b1t[4], g0s[4], g1s[4];
#pragma unroll
        for (int r = 0; r < 4; ++r) { const int t = mt * 16 + 4 * q + r; g0t[r] = SG[t]; g1t[r] = SG[64 + t]; b0t[r] = SG[128 + t]; b1t[r] = SG[192 + t]; }
#pragma unroll
        for (int nt = 0; nt < 4; ++nt) { g0s[nt] = SG[nt * 16 + c]; g1s[nt] = SG[64 + nt * 16 + c]; }
#pragma unroll
        for (int nt = 0; nt < 4; ++nt)
#pragma unroll
            for (int r = 0; r < 4; ++r) { const int t = mt * 16 + 4 * q + r, s = nt * 16 + c; const float v = acc[nt][r];
                const float e0 = __expf(fminf(g0t[r] - g0s[nt], 0.f)) * (s <= t ? 1.f : 0.f), e1 = __expf(fminf(g1t[r] - g1s[nt], 0.f)) * (s >= t ? 1.f : 0.f);
                if (!isq) { ((LAS float*)(L + L0))[t * 64 + s] = (s < t ? b0t[r] : 0.f) * e0 * v; ((LAS float*)(L + L1))[(63 - t) * 64 + (63 - s)] = (s > t ? b1t[r] : 0.f) * e1 * v; }
                else { *(LAS bf16*)(L + QKM0 + t64_off(t, s)) = (bf16)f2bf(e0 * v); *(LAS bf16*)(L + QKM0 + 8192 + t64_off(t, s)) = (bf16)f2bf(e1 * v); } }
    }
    __syncthreads();
    gdn_inverse_blk(L, L0, TK0, SG, tid);
    __syncthreads();
    for (int d = 0; d < 2; ++d) {
        const int pid = (gc * 4 + h) * 2 + d;
        const LAS unsigned char* TKd = L + TK0 + d * 16384; const LAS unsigned char* TVd = TKd + 8192; const LAS unsigned char* QKMd = L + QKM0 + d * 8192;
        {
            int lane = C.lane; asm volatile("" : "+v"(lane)); const int q = lane >> 4, c = lane & 15;
            f32x4 aw[4], au[4];
#pragma unroll
            for (int nt = 0; nt < 4; ++nt) { aw[nt] = (f32x4){0.f, 0.f, 0.f, 0.f}; au[nt] = (f32x4){0.f, 0.f, 0.f, 0.f}; }
#pragma unroll
            for (int ks = 0; ks < 2; ++ks) { const bf16x8 ak = frag64(L + KT, w * 16, ks * 32, lane), av = frag64(L + VT, w * 16, ks * 32, lane);
#pragma unroll
                for (int nt = 0; nt < 4; ++nt) { aw[nt] = MFMA16(ak, frag64(TKd, nt * 16, ks * 32, lane), aw[nt]); au[nt] = MFMA16(av, frag64(TVd, nt * 16, ks * 32, lane), au[nt]); } }
#pragma unroll
            for (int nt = 0; nt < 4; ++nt)
#pragma unroll
                for (int r = 0; r < 4; ++r) { const int dd = w * 16 + 4 * q + r, i = nt * 16 + c;
                    *(LAS bf16*)(L + WT + t64_off(dd, i)) = (bf16)f2bf(aw[nt][r]); *(LAS bf16*)(L + UT + t64_off(dd, i)) = (bf16)f2bf(au[nt][r]); }
#pragma unroll
            for (int it = 0; it < 2; ++it) { const int idx = tid + it * NTHR, a = idx >> 3, ch = idx & 7, off = a * 128 + ((ch ^ ((a >> 1) & 7)) << 4);
                const v4u x = *(const LAS v4u*)(L + KT + off); const LAS float* cd = SG + 384 + d * 64 + ch * 8;
                v4u o; o.x = pk2(bflo(x.x) * cd[0], bfhi(x.x) * cd[1]); o.y = pk2(bflo(x.y) * cd[2], bfhi(x.y) * cd[3]); o.z = pk2(bflo(x.z) * cd[4], bfhi(x.z) * cd[5]); o.w = pk2(bflo(x.w) * cd[6], bfhi(x.w) * cd[7]);
                *(LAS v4u*)(L + KB + off) = o; }
        }
        __syncthreads();
        {
            int lane = C.lane; asm volatile("" : "+v"(lane)); const int q = lane >> 4, c = lane & 15;
            bf16x8 bq[4][2];
#pragma unroll
            for (int nt = 0; nt < 4; ++nt)
#pragma unroll
                for (int ks = 0; ks < 2; ++ks) bq[nt][ks] = frag64(QKMd, nt * 16, ks * 32, lane);
            f32x4 ao[4], al[4];
#pragma unroll
            for (int nt = 0; nt < 4; ++nt) { ao[nt] = (f32x4){0.f, 0.f, 0.f, 0.f}; al[nt] = (f32x4){0.f, 0.f, 0.f, 0.f}; }
#pragma unroll
            for (int ks = 0; ks < 2; ++ks) { const bf16x8 a1 = frag64(L + WT, w * 16, ks * 32, lane), a2 = frag64(L + UT, w * 16, ks * 32, lane);
#pragma unroll
                for (int nt = 0; nt < 4; ++nt) { ao[nt] = MFMA16(a1, bq[nt][ks], ao[nt]); al[nt] = MFMA16(a2, bq[nt][ks], al[nt]); } }
            bf16* goq = C.wsb(WS_GOQ) + (size_t)pid * 8192; bf16* ogdn = C.wsb(WS_OGDN) + ((size_t)d * M + ci.row0) * 512 + h * 128 + w * 16 + 4 * q;
#pragma unroll
            for (int nt = 0; nt < 4; ++nt) { const int i = nt * 16 + c; const float egi = SG[256 + d * 64 + i];
                const v2u qv = *(const LAS v2u*)(L + QB + t128_off(i, w * 16 + 4 * q));
                v2u o; o.x = pk2(egi * bflo(qv.x) - ao[nt][0], egi * bfhi(qv.x) - ao[nt][1]); o.y = pk2(egi * bflo(qv.y) - ao[nt][2], egi * bfhi(qv.y) - ao[nt][3]);
                *(v2u*)(goq + ((nt * 4 + (w >> 1)) * 64 + q * 16 + c) * 8 + 4 * (w & 1)) = o;
                v2u ol_; ol_.x = pk2(al[nt][0], al[nt][1]); ol_.y = pk2(al[nt][2], al[nt][3]); *(v2u*)(ogdn + (size_t)i * 512) = ol_; }
        }
#ifndef NO_RQ
        {
            int lane = C.lane; asm volatile("" : "+v"(lane)); const int q = lane >> 4, c = lane & 15;
            f32x4 ar[8], aq2[8];
#pragma unroll
            for (int nt = 0; nt < 8; ++nt) { ar[nt] = (f32x4){0.f, 0.f, 0.f, 0.f}; aq2[nt] = (f32x4){0.f, 0.f, 0.f, 0.f}; }
#pragma unroll
            for (int ks = 0; ks < 2; ++ks) { const bf16x8 a1 = frag64(L + WT, w * 16, ks * 32, lane), a2 = frag64(L + KB, w * 16, ks * 32, lane);
#pragma unroll
                for (int nt = 0; nt < 8; ++nt) { ar[nt] = MFMA16(a1, frag64(L + KB, nt * 16, ks * 32, lane), ar[nt]); aq2[nt] = MFMA16(a2, frag64(L + UT, nt * 16, ks * 32, lane), aq2[nt]); } }
            bf16* gr = C.wsb(WS_GR) + (size_t)pid * 16384; bf16* gq = C.wsb(WS_GQ) + (size_t)pid * 16384;
#pragma unroll
            for (int nt = 0; nt < 8; ++nt) { v2u o; o.x = pk2(-ar[nt][0], -ar[nt][1]); o.y = pk2(-ar[nt][2], -ar[nt][3]);
                *(v2u*)(gr + ((nt * 4 + (w >> 1)) * 64 + q * 16 + c) * 8 + 4 * (w & 1)) = o;
                v2u p; p.x = pk2(aq2[nt][0], aq2[nt][1]); p.y = pk2(aq2[nt][2], aq2[nt][3]);
                *(v2u*)(gq + ((nt * 8 + w) * 64 + lane) * 4) = p; }
        }
#endif
        if (tid == 0) C.wsf(WS_GEGL)[pid] = SG[512 + d];
        __syncthreads();
    }
}

struct ScanQo { v2u qv[8]; v2u ol[4]; float egl; };
__device__ __forceinline__ void gl16(v4u& d, const void* p) { asm volatile("global_load_dwordx4 %0, %1, off" : "=v"(d) : "v"(p) : "memory"); }
__device__ __forceinline__ void gl8(v2u& d, const void* p) { asm volatile("global_load_dwordx2 %0, %1, off" : "=v"(d) : "v"(p) : "memory"); }
template <int IMM> __device__ __forceinline__ void gl8s(v2u& d, unsigned voff, const void* sbase) { asm volatile("global_load_dwordx2 %0, %1, %2 offset:%3" : "=v"(d) : "v"(voff), "s"(sbase), "i"(IMM) : "memory"); }
__device__ __forceinline__ void gl4(float& d, const void* p) { asm volatile("global_load_dword %0, %1, off" : "=v"(d) : "v"(p) : "memory"); }
__device__ __forceinline__ void gdn_scan_unit(Ctx& C, int l, int seq, int h, int d, bool dry) {
    LAS unsigned char* L = C.lds;
    const int tid = C.tid, lane = C.lane, w = C.wave, q = lane >> 4, c = lane & 15;
    const int lat = seq >= 16, nc = lat ? 32 : 4, gc0 = lat ? 64 + (seq - 16) * 32 : seq * 4;
    const unsigned char* GRb = (const unsigned char*)C.wsb(WS_GR); const unsigned char* GOQb = (const unsigned char*)C.wsb(WS_GOQ);
    const bf16* GQp = C.wsb(WS_GQ); const float* GEGL = C.wsf(WS_GEGL); bf16* OG = C.wsb(WS_OGDN);
    f32x4 acc[8];
#pragma unroll
    for (int mt = 0; mt < 8; ++mt) acc[mt] = (f32x4){0.f, 0.f, 0.f, 0.f};
    if (lat) { const float* sp = C.inp(I_SGDN) + ((((size_t)(seq - 16) * 2 + l) * 2 + d) * 4 + h) * 16384 + w * 16 + c;
#pragma unroll
        for (int mt = 0; mt < 8; ++mt)
#pragma unroll
            for (int r = 0; r < 4; ++r) acc[mt][r] = sp[(size_t)(mt * 16 + 4 * q + r) * 128]; }
    asm volatile("s_waitcnt vmcnt(0)" ::: "memory");
#define SC_GC(n) (gc0 + (d ? nc - 1 - ((n) < nc ? (n) : nc - 1) : ((n) < nc ? (n) : nc - 1)))
#define SC_DMA(n) { const int pid_ = (SC_GC(n) * 4 + h) * 2 + d; LAS unsigned char* Bn_ = L + ((n) % 3) * 49152 + w * 1024; _Pragma("unroll") for (int k = 0; k < 6; ++k) \
        __builtin_amdgcn_global_load_lds((const unsigned*)(k < 4 ? GRb + (size_t)pid_ * 32768 + (k * NTHR + tid) * 16 : GOQb + (size_t)pid_ * 16384 + ((k - 4) * NTHR + tid) * 16), (LAS unsigned*)(Bn_ + k * 8192), 16, 0, 0); }
#define SC_WAIT_QO(Q, N) asm volatile("s_waitcnt vmcnt(" #N ")" : "+v"(Q.qv[0]), "+v"(Q.qv[1]), "+v"(Q.qv[2]), "+v"(Q.qv[3]), "+v"(Q.qv[4]), "+v"(Q.qv[5]), "+v"(Q.qv[6]), "+v"(Q.qv[7]), \
        "+v"(Q.ol[0]), "+v"(Q.ol[1]), "+v"(Q.ol[2]), "+v"(Q.ol[3]), "+v"(Q.egl) :: "memory");
#define SC_LOAD_QO(Q, n) { const int gc_ = SC_GC(n), pid_ = (gc_ * 4 + h) * 2 + d; \
        { const unsigned vo_ = (unsigned)(((w * 8) * 64 + lane) * 8); const void* sb_ = (const void*)(GQp + (size_t)pid_ * 16384); asm volatile("s_nop 4" ::: "memory"); \
          gl8s<0>(Q.qv[0], vo_, sb_); gl8s<512>(Q.qv[1], vo_, sb_); gl8s<1024>(Q.qv[2], vo_, sb_); gl8s<1536>(Q.qv[3], vo_, sb_); gl8s<2048>(Q.qv[4], vo_, sb_); gl8s<2560>(Q.qv[5], vo_, sb_); gl8s<3072>(Q.qv[6], vo_, sb_); gl8s<3584>(Q.qv[7], vo_, sb_); } \
        const bf16* op_ = OG + ((size_t)d * M + gc_ * 64 + c) * 512 + h * 128 + w * 16 + 4 * q; \
        _Pragma("unroll") for (int nt = 0; nt < 4; ++nt) gl8(Q.ol[nt], op_ + (size_t)nt * 16 * 512); gl4(Q.egl, GEGL + pid_); }
#define SC_STEP(n, Q) { const int gc_s = SC_GC(n); const LAS unsigned char* B = L + ((n) % 3) * 49152; \
        bf16x8 sb[4]; \
        _Pragma("unroll") for (int ks = 0; ks < 4; ++ks) { v4u p_; p_.x = pk2v(acc[2 * ks][0], acc[2 * ks][1]); p_.y = pk2v(acc[2 * ks][2], acc[2 * ks][3]); p_.z = pk2v(acc[2 * ks + 1][0], acc[2 * ks + 1][1]); p_.w = pk2v(acc[2 * ks + 1][2], acc[2 * ks + 1][3]);     sb[ks] = __builtin_bit_cast(bf16x8, p_); } \
        SC_WAIT_QO(Q, 33) \
        f32x4 oacc[4]; \
        _Pragma("unroll") for (int nt = 0; nt < 4; ++nt) { oacc[nt][0] = bflo(Q.ol[nt].x); oacc[nt][1] = bfhi(Q.ol[nt].x); oacc[nt][2] = bflo(Q.ol[nt].y); oacc[nt][3] = bfhi(Q.ol[nt].y); } \
        _Pragma("unroll") for (int mt = 0; mt < 8; ++mt) { const float e_ = Q.egl; acc[mt][0] = e_ * acc[mt][0] + bflo(Q.qv[mt].x); acc[mt][1] = e_ * acc[mt][1] + bfhi(Q.qv[mt].x); acc[mt][2] = e_ * acc[mt][2] + bflo(Q.qv[mt].y); acc[mt][3] = e_ * acc[mt][3] + bfhi(Q.qv[mt].y); } \
        SC_LOAD_QO(Q, (n) + 2) \
        SC_DMA((n) + 2) \
        bf16* op_s = OG + ((size_t)d * M + gc_s * 64 + c) * 512 + h * 128 + w * 16 + 4 * q; \
        { v2u ost_[4]; \
          _Pragma("unroll") for (int hb = 0; hb < 2; ++hb) { bf16x8 f_[8]; \
            _Pragma("unroll") for (int i_ = 0; i_ < 8; ++i_) f_[i_] = *(const LAS bf16x8*)(B + 32768 + ((hb * 8 + i_) * 64 + lane) * 16); \
            __builtin_amdgcn_sched_barrier(0); \
            _Pragma("unroll") for (int n2 = 0; n2 < 2; ++n2) { const int nt = hb * 2 + n2; f32x4 o_ = oacc[nt]; \
                _Pragma("unroll") for (int ks = 0; ks < 4; ++ks) o_ = MFMA16(sb[ks], f_[n2 * 4 + ks], o_); \
                if (dry) o_ = oacc[nt]; ost_[nt].x = pk2(o_[0], o_[1]); ost_[nt].y = pk2(o_[2], o_[3]); } \
            __builtin_amdgcn_sched_barrier(0); } \
          _Pragma("unroll") for (int nt = 0; nt < 4; ++nt) *(v2u*)(op_s + (size_t)nt * 16 * 512) = ost_[nt]; } \
        _Pragma("unroll") for (int hb = 0; hb < 4; ++hb) { bf16x8 f_[8]; \
          _Pragma("unroll") for (int i_ = 0; i_ < 8; ++i_) f_[i_] = *(const LAS bf16x8*)(B + ((hb * 8 + i_) * 64 + lane) * 16); \
          __builtin_amdgcn_sched_barrier(0); \
          _Pragma("unroll") for (int m2 = 0; m2 < 2; ++m2) { f32x4 a_ = acc[hb * 2 + m2]; \
              _Pragma("unroll") for (int ks = 0; ks < 4; ++ks) a_ = MFMA16(f_[m2 * 4 + ks], sb[ks], a_); \
              acc[hb * 2 + m2] = a_; } \
          __builtin_amdgcn_sched_barrier(0); } \
        asm volatile("s_waitcnt vmcnt(27) lgkmcnt(0)" ::: "memory"); __builtin_amdgcn_s_barrier(); asm volatile("" ::: "memory"); }
    ScanQo q0, q1;
    SC_LOAD_QO(q0, 0) SC_LOAD_QO(q1, 1) SC_DMA(0) SC_DMA(1)
    SC_WAIT_QO(q0, 0) SC_WAIT_QO(q1, 0)
    asm volatile("s_waitcnt vmcnt(0) lgkmcnt(0)" ::: "memory"); __builtin_amdgcn_s_barrier(); asm volatile("" ::: "memory");
#pragma unroll 1
    for (int cc = 0; cc < nc; cc += 2) { SC_STEP(cc, q0) SC_STEP(cc + 1, q1) }
#undef SC_GC
#undef SC_DMA
#undef SC_WAIT_QO
#undef SC_LOAD_QO
#undef SC_STEP
    asm volatile("s_waitcnt vmcnt(0) lgkmcnt(0)" ::: "memory");
    if (!lat && !dry) { float* sp = C.outp() + O_SGDN + ((((size_t)seq * 2 + l) * 2 + d) * 4 + h) * 16384 + w * 16 + c;
#pragma unroll
        for (int mt = 0; mt < 8; ++mt)
#pragma unroll
            for (int r = 0; r < 4; ++r) sp[(size_t)(mt * 16 + 4 * q + r) * 128] = acc[mt][r]; }
    __syncthreads();
}
__device__ __forceinline__ int t32_off(int row, int col) { return row * 64 + (((col >> 3) ^ ((row >> 2) & 3)) << 4) + (col & 7) * 2; }
__device__ __forceinline__ bf16x8 frag32(const LAS unsigned char* T, int r0, int lane) { const int r = lane & 15, q = lane >> 4; return *(const LAS bf16x8*)(T + (r0 + r) * 64 + ((q ^ ((r >> 2) & 3)) << 4)); }
constexpr int GL_BC = 0, GL_TOT = 16384, GL_VT = 16896, GL_T0 = 25088;
__device__ __forceinline__ void gla_gates(Ctx& C, int l, const ChunkInfo& ci, int h, const bf16* PROJ) {
    LAS float* BC = (LAS float*)(C.lds + GL_BC); LAS float* TOT = (LAS float*)(C.lds + GL_TOT);
    int lane = C.lane; asm volatile("" : "+v"(lane)); const int w = C.wave, t = lane;
    const bf16* pr = PROJ + (size_t)(ci.row0 + t) * NINP;
    float lg[2][4];
#pragma unroll
    for (int d = 0; d < 2; ++d) {
        float lr[16]; load16bf(pr + (d ? C_GLRB : C_GLRF), lr);
        const float* up = C.inp(I_GKUP) + (size_t)(l * 2 + d) * 16 * 128 + h * 32 + w * 4;
        f32x4 upv[16];
#pragma unroll
        for (int r = 0; r < 16; ++r) upv[r] = *(const f32x4*)(up + r * 128);
        f32x4 z = *(const f32x4*)(C.inp(I_GKB) + (l * 2 + d) * 128 + h * 32 + w * 4);
#pragma unroll
        for (int r = 0; r < 16; ++r) z = z + upv[r] * lr[r];
#pragma unroll
        for (int e = 0; e < 4; ++e) lg[d][e] = (fminf(z[e], 0.f) - __logf(1.0f + __expf(-fabsf(z[e])))) * (1.0f / 16.0f); }
    float ps[2][4];
#pragma unroll
    for (int d = 0; d < 2; ++d)
#pragma unroll
        for (int e = 0; e < 4; ++e) ps[d][e] = lg[d][e];
#pragma unroll
    for (int off = 1; off < 64; off <<= 1) { const int src = t >= off ? t - off : t; float v[2][4];
#pragma unroll
        for (int d = 0; d < 2; ++d)
#pragma unroll
            for (int e = 0; e < 4; ++e) v[d][e] = lane_read(ps[d][e], src);
#pragma unroll
        for (int d = 0; d < 2; ++d)
#pragma unroll
            for (int e = 0; e < 4; ++e) if (t >= off) ps[d][e] += v[d][e]; }
#pragma unroll
    for (int d = 0; d < 2; ++d)
#pragma unroll
        for (int e = 0; e < 4; ++e) { const float tot = lane_read(ps[d][e], 63);
            BC[(d * 64 + t) * 32 + w * 4 + e] = d ? (tot - ps[d][e] + lg[d][e]) : ps[d][e];
            if (t == 0) TOT[d * 32 + w * 4 + e] = tot; }
}
__device__ __forceinline__ void gla_load_vt(Ctx& C, const ChunkInfo& ci, int h, const bf16* PROJ) {
    const int t = C.tid >> 3, e8 = (C.tid & 7) * 8; float v[8];
    { const v4u a = *(const v4u*)(PROJ + (size_t)(ci.row0 + t) * NINP + C_GV + h * 64 + e8); v[0] = bflo(a.x); v[1] = bfhi(a.x); v[2] = bflo(a.y); v[3] = bfhi(a.y); v[4] = bflo(a.z); v[5] = bfhi(a.z); v[6] = bflo(a.w); v[7] = bfhi(a.w); }
#pragma unroll
    for (int i = 0; i < 8; ++i) *(LAS bf16*)(C.lds + GL_VT + t64_off(e8 + i, t)) = (bf16)f2bf(v[i]);
}
__device__ __forceinline__ void gla_prep_item(Ctx& C, int l, int gc, int h) {
    const ChunkInfo ci = chunk_info(gc); const bf16* PROJ = C.wsb(WS_PROJ);
    LAS float* BC = (LAS float*)(C.lds + GL_BC); LAS float* TOT = (LAS float*)(C.lds + GL_TOT);
    LAS unsigned char* KHT = C.lds + GL_T0;
    const v2u kv = *(const v2u*)(PROJ + (size_t)(ci.row0 + (C.tid >> 3)) * NINP + C_GK + h * 32 + (C.tid & 7) * 4);
    gla_gates(C, l, ci, h, PROJ); gla_load_vt(C, ci, h, PROJ);
    __syncthreads();
    { const int t = C.tid >> 3, dk4 = (C.tid & 7) * 4;
      const float k4[4] = {bflo(kv.x), bfhi(kv.x), bflo(kv.y), bfhi(kv.y)};
#pragma unroll
      for (int d = 0; d < 2; ++d)
#pragma unroll
          for (int e = 0; e < 4; ++e) *(LAS bf16*)(KHT + d * 4096 + t64_off(dk4 + e, t)) = (bf16)f2bf(k4[e] * __expf(TOT[d * 32 + dk4 + e] - BC[(d * 64 + t) * 32 + dk4 + e])); }
    __syncthreads();
    { int lane = C.lane; asm volatile("" : "+v"(lane)); const int q = lane >> 4, c = lane & 15, w = C.wave, d = w >> 2, mt = (w >> 1) & 1, nt0 = (w & 1) * 2;
      const int pid = (gc * 4 + h) * 2 + d; float* ds = C.wsf(WS_GLADS) + (size_t)pid * 2048;
      f32x4 acc[2] = {{0.f, 0.f, 0.f, 0.f}, {0.f, 0.f, 0.f, 0.f}};
#pragma unroll
      for (int ks = 0; ks < 2; ++ks) { const bf16x8 a = frag64(KHT + d * 4096, mt * 16, ks * 32, lane);
#pragma unroll
          for (int n = 0; n < 2; ++n) acc[n] = MFMA16(a, frag64(C.lds + GL_VT, (nt0 + n) * 16, ks * 32, lane), acc[n]); }
#pragma unroll
      for (int n = 0; n < 2; ++n)
#pragma unroll
          for (int r = 0; r < 4; ++r) ds[(mt * 16 + 4 * q + r) * 64 + (nt0 + n) * 16 + c] = acc[n][r];
      if (C.tid < 64) { const int dd = C.tid >> 5, dk = C.tid & 31; C.wsf(WS_GLADV)[((gc * 4 + h) * 2 + dd) * 32 + dk] = __expf(TOT[dd * 32 + dk]); } }
    __syncthreads();
}
struct S5Par { double lbr, lbi; float bre[16], bim[16]; };
__device__ __forceinline__ void s5_setup(Ctx& C, int l, int d, int g, int p, S5Par& P) {
    const int gi = (l * 2 + d) * 16 + g;
    const double lre = (double)C.inp(I_LRE)[gi * 64 + p], lim = (double)C.inp(I_LIM)[gi * 64 + p];
    const double step = (double)__expf(C.inp(I_LSTEP)[gi]);
    const double a = lre * step, ang = lim * step;
    const double ea = 1.0 + a * (1.0 + a * (0.5 + a * (1.0 / 6 + a * (1.0 / 24 + a * (1.0 / 120 + a * (1.0 / 720 + a * (1.0 / 5040 + a * (1.0 / 40320 + a * (1.0 / 362880)))))))));
    const double TWO_PI = 6.283185307179586476925286766559, INV_TWO_PI = 0.15915494309189533576888376337251;
    const double kk = rint(ang * INV_TWO_PI); const double r = (ang - kk * TWO_PI) * 0.125, r2 = r * r;
    double sn = r * (1.0 + r2 * (-1.0 / 6 + r2 * (1.0 / 120 + r2 * (-1.0 / 5040 + r2 * (1.0 / 362880 + r2 * (-1.0 / 39916800 + r2 * (1.0 / 6227020800.0)))))));
    double cs = 1.0 + r2 * (-0.5 + r2 * (1.0 / 24 + r2 * (-1.0 / 720 + r2 * (1.0 / 40320 + r2 * (-1.0 / 3628800 + r2 * (1.0 / 479001600.0 + r2 * (-1.0 / 87178291200.0)))))));
#pragma unroll
    for (int n = 0; n < 3; ++n) { const double s2 = 2.0 * sn * cs, c2 = cs * cs - sn * sn; sn = s2; cs = c2; }
    P.lbr = ea * cs; P.lbi = ea * sn;
    const double nr = P.lbr - 1.0, ni = P.lbi, den = lre * lre + lim * lim;
    double rden = (double)__builtin_amdgcn_rcpf((float)den); rden = rden * (2.0 - den * rden); rden = rden * (2.0 - den * rden);
    const float cfr = (float)((nr * lre + ni * lim) * rden), cfi = (float)((ni * lre - nr * lim) * rden);
    const float* br = C.inp(I_BRE) + ((size_t)gi * 64 + p) * 16; const float* bi = C.inp(I_BIM) + ((size_t)gi * 64 + p) * 16;
#pragma unroll
    for (int ch = 0; ch < 16; ++ch) { P.bre[ch] = cfr * br[ch] - cfi * bi[ch]; P.bim[ch] = cfr * bi[ch] + cfi * br[ch]; }
}
constexpr int S5_BB = 0, S5_CB = 8192, S5_BUT = 12288, S5_HT = S5_BUT + 8 * 8448;
__device__ __forceinline__ void s5_write_bb(const S5Par& P, LAS unsigned char* BB, int p) {
    v4u z = {0u, 0u, 0u, 0u}; v4u r0, r1, i0, i1;
    r0.x = pk2(P.bre[0], P.bre[1]); r0.y = pk2(P.bre[2], P.bre[3]); r0.z = pk2(P.bre[4], P.bre[5]); r0.w = pk2(P.bre[6], P.bre[7]);
    r1.x = pk2(P.bre[8], P.bre[9]); r1.y = pk2(P.bre[10], P.bre[11]); r1.z = pk2(P.bre[12], P.bre[13]); r1.w = pk2(P.bre[14], P.bre[15]);
    i0.x = pk2(P.bim[0], P.bim[1]); i0.y = pk2(P.bim[2], P.bim[3]); i0.z = pk2(P.bim[4], P.bim[5]); i0.w = pk2(P.bim[6], P.bim[7]);
    i1.x = pk2(P.bim[8], P.bim[9]); i1.y = pk2(P.bim[10], P.bim[11]); i1.z = pk2(P.bim[12], P.bim[13]); i1.w = pk2(P.bim[14], P.bim[15]);
    LAS v4u* rr = (LAS v4u*)(BB + p * 64); rr[0] = r0; rr[1] = r1; rr[2] = z; rr[3] = z;
    LAS v4u* ri = (LAS v4u*)(BB + (64 + p) * 64); ri[0] = i0; ri[1] = i1; ri[2] = z; ri[3] = z;
}
__device__ __forceinline__ bf16x8 s5_load_uf(const bf16* PROJ, int gc, int g, int tb, int lane) {
    const int q = lane >> 4, c = lane & 15; bf16x8 uf = {0, 0, 0, 0, 0, 0, 0, 0};
    if (q < 2) uf = *(const bf16x8*)(PROJ + (size_t)(gc * 64 + tb + c) * NINP + C_SU + g * 16 + 8 * q);
    return uf;
}
__device__ __forceinline__ void s5_bu_quarter(bf16x8 uf, const LAS unsigned char* BB, LAS float* BUT, int lane) {
    const int q = lane >> 4, c = lane & 15;
    bf16x8 bf[8];
#pragma unroll
    for (int nt = 0; nt < 8; ++nt) bf[nt] = *(const LAS bf16x8*)(BB + (nt * 16 + c) * 64 + q * 16);
#pragma unroll
    for (int nt = 0; nt < 8; ++nt) { f32x4 acc = {0.f, 0.f, 0.f, 0.f}; acc = MFMA16(bf[nt], uf, acc);
        *(LAS f32x4*)(BUT + c * 132 + nt * 16 + 4 * q) = acc; }
    asm volatile("s_waitcnt lgkmcnt(0)" ::: "memory");
}
__device__ __forceinline__ void s5_prep_blk(Ctx& C, int l, int bi) {
    const int gd = bi & 31, g = gd >> 1, d = gd & 1, cg = bi >> 5, p = C.lane;
    LAS unsigned char* BB = C.lds + S5_BB; LAS float* BUT = (LAS float*)(C.lds + S5_BUT + C.wave * 8448);
    const bf16* PROJ = C.wsb(WS_PROJ); float* S5E = C.wsf(WS_S5E);
    S5Par P; s5_setup(C, l, d, g, p, P);
    if (C.wave == 0) s5_write_bb(P, BB, p);
    __syncthreads();
    const float lbr = (float)P.lbr, lbi = (float)P.lbi;
    bf16x8 ufr[2][4];
#pragma unroll
    for (int j = 0; j < 2; ++j)
#pragma unroll
        for (int qq = 0; qq < 4; ++qq) ufr[j][qq] = s5_load_uf(PROJ, cg * 16 + C.wave * 2 + j, g, d ? 48 - 16 * qq : 16 * qq, p);
#pragma unroll
    for (int j = 0; j < 2; ++j) { const int gc = cg * 16 + C.wave * 2 + j; const size_t item = (size_t)(gc * 16 + g) * 2 + d;
        float hr = 0.f, hi = 0.f;
#pragma unroll
        for (int qq = 0; qq < 4; ++qq) { const int tb = d ? 48 - 16 * qq : 16 * qq;
            s5_bu_quarter(ufr[j][qq], BB, BUT, p);
#pragma unroll
            for (int ii = 0; ii < 16; ++ii) { const int tl = d ? 15 - ii : ii; const float br = BUT[tl * 132 + p], bi2 = BUT[tl * 132 + 64 + p];
                const float nr = lbr * hr - lbi * hi + br, ni = lbr * hi + lbi * hr + bi2; hr = nr; hi = ni; }
            asm volatile("s_waitcnt lgkmcnt(0)" ::: "memory"); }
        S5E[item * 128 + p] = hr; S5E[item * 128 + 64 + p] = hi; }
    __syncthreads();
}
__device__ __forceinline__ void ph_prep(Ctx& C, int l) {
    for (int it = C.vb; it < 256; it += C.nb) gdn_prep_item(C, l, 64 + (it >> 2), it & 3);
    for (int it = C.vb; it < 512; it += C.nb) gla_prep_item(C, l, it >> 2, it & 3);
    for (int bi = C.vb; bi < 256; bi += C.nb) s5_prep_blk(C, l, bi);
}

__device__ __forceinline__ void gla_scan_unit(Ctx& C, int l, int seq, int h, int d) {
    const int tid = C.tid; const int lat = seq >= 16, nc = lat ? 32 : 4, gc0 = lat ? 64 + (seq - 16) * 32 : seq * 4;
    const int dk = tid >> 4, e0 = (tid & 15) * 4;
    float* GLASC = C.wsf(WS_GLASC); const float* GLADS = C.wsf(WS_GLADS); const float* GLADV = C.wsf(WS_GLADV);
    f32x4 s = {0.f, 0.f, 0.f, 0.f};
    if (lat) s = *(const f32x4*)(C.inp(I_SGLA) + (((((size_t)(seq - 16) * 2 + l) * 2 + d) * 4 + h) * 32 + dk) * 64 + e0);
    for (int c0 = 0; c0 < nc; c0 += 4) {
        float dv[4]; f32x4 ds[4];
#pragma unroll
        for (int k = 0; k < 4; ++k) { const int cc = c0 + k, gc = gc0 + (d ? nc - 1 - cc : cc), pid = (gc * 4 + h) * 2 + d; dv[k] = GLADV[pid * 32 + dk]; ds[k] = *(const f32x4*)(GLADS + (size_t)pid * 2048 + dk * 64 + e0); }
#pragma unroll
        for (int k = 0; k < 4; ++k) { const int cc = c0 + k, gc = gc0 + (d ? nc - 1 - cc : cc), pid = (gc * 4 + h) * 2 + d;
            *(f32x4*)(GLASC + (size_t)pid * 2048 + dk * 64 + e0) = s; s = s * dv[k] + ds[k]; } }
    if (!lat) *(f32x4*)(C.outp() + O_SGLA + (((((size_t)seq * 2 + l) * 2 + d) * 4 + h) * 32 + dk) * 64 + e0) = s;
}
__device__ __forceinline__ void s5_scan_unit(Ctx& C, int l, int unit) {
    const int d = unit & 1, g = (unit >> 1) & 15, seq = unit >> 5, p = C.lane;
    const int lat = seq >= 16, nc = lat ? 32 : 4, gc0 = lat ? 64 + (seq - 16) * 32 : seq * 4;
    const float* S5E = C.wsf(WS_S5E); float* S5HS = C.wsf(WS_S5HS);
    S5Par P; s5_setup(C, l, d, g, p, P);
    double pr = P.lbr, pi = P.lbi;
#pragma unroll
    for (int n = 0; n < 6; ++n) { const double r2 = pr * pr - pi * pi, i2 = 2.0 * pr * pi; pr = r2; pi = i2; }
    const float l64r = (float)pr, l64i = (float)pi;
    float hr = 0.f, hi = 0.f;
    if (lat) { const size_t o = ((((size_t)(seq - 16) * 2 + l) * 2 + d) * 16 + g) * 64 + p; hr = C.inp(I_S5RE)[o]; hi = C.inp(I_S5IM)[o]; }
    for (int c0 = 0; c0 < nc; c0 += 4) {
        float er[4], ei[4];
#pragma unroll
        for (int k = 0; k < 4; ++k) { const int cc = c0 + k, gc = gc0 + (d ? nc - 1 - cc : cc); const size_t item = (size_t)(gc * 16 + g) * 2 + d; er[k] = S5E[item * 128 + p]; ei[k] = S5E[item * 128 + 64 + p]; }
#pragma unroll
        for (int k = 0; k < 4; ++k) { const int cc = c0 + k, gc = gc0 + (d ? nc - 1 - cc : cc); const size_t item = (size_t)(gc * 16 + g) * 2 + d;
            S5HS[item * 128 + p] = hr; S5HS[item * 128 + 64 + p] = hi;
            const float nr = l64r * hr - l64i * hi + er[k], ni = l64r * hi + l64i * hr + ei[k]; hr = nr; hi = ni; } }
    if (!lat) { const size_t o = ((((size_t)seq * 2 + l) * 2 + d) * 16 + g) * 64 + p; C.outp()[O_S5RE + o] = hr; C.outp()[O_S5IM + o] = hi; }
}
__device__ __forceinline__ void gla_out_item(Ctx& C, int l, int gc, int h) {
    const ChunkInfo ci = chunk_info(gc); const bf16* PROJ = C.wsb(WS_PROJ);
    LAS float* BC = (LAS float*)(C.lds + GL_BC);
    LAS unsigned char* QT = C.lds + GL_T0;
    LAS unsigned char* KT = QT + 8192;
    LAS unsigned char* SCT = KT + 8192;
    LAS unsigned char* AM = SCT + 8192;
    v2u qv, kv; f32x4 scv[2];
    { const int t = C.tid >> 3, dk4 = (C.tid & 7) * 4; const bf16* pr = PROJ + (size_t)(ci.row0 + t) * NINP;
      qv = *(const v2u*)(pr + C_GQ + h * 32 + dk4); kv = *(const v2u*)(pr + C_GK + h * 32 + dk4);
      const int dk = C.tid >> 4, e4 = (C.tid & 15) * 4;
#pragma unroll
      for (int d = 0; d < 2; ++d) scv[d] = *(const f32x4*)(C.wsf(WS_GLASC) + (size_t)((gc * 4 + h) * 2 + d) * 2048 + dk * 64 + e4); }
    gla_gates(C, l, ci, h, PROJ); gla_load_vt(C, ci, h, PROJ);
    __syncthreads();
    { const int t = C.tid >> 3, dk4 = (C.tid & 7) * 4;
      const float q4[4] = {bflo(qv.x), bfhi(qv.x), bflo(qv.y), bfhi(qv.y)}, k4[4] = {bflo(kv.x), bfhi(kv.x), bflo(kv.y), bfhi(kv.y)};
#pragma unroll
      for (int d = 0; d < 2; ++d) { float eb[4];
#pragma unroll
          for (int e = 0; e < 4; ++e) eb[e] = BC[(d * 64 + t) * 32 + dk4 + e];
          v2u qo, ko; qo.x = pk2(q4[0] * 0.17677669529663687f * __expf(eb[0]), q4[1] * 0.17677669529663687f * __expf(eb[1])); qo.y = pk2(q4[2] * 0.17677669529663687f * __expf(eb[2]), q4[3] * 0.17677669529663687f * __expf(eb[3]));
          ko.x = pk2(k4[0] * __expf(-eb[0]), k4[1] * __expf(-eb[1])); ko.y = pk2(k4[2] * __expf(-eb[2]), k4[3] * __expf(-eb[3]));
          *(LAS v2u*)(QT + d * 4096 + t32_off(t, dk4)) = qo; *(LAS v2u*)(KT + d * 4096 + t32_off(t, dk4)) = ko; }
      const int dk = C.tid >> 4, e4 = (C.tid & 15) * 4;
#pragma unroll
      for (int d = 0; d < 2; ++d) { const f32x4 sv = scv[d];
          *(LAS bf16*)(SCT + d * 4096 + t32_off(e4, dk)) = (bf16)f2bf(sv.x); *(LAS bf16*)(SCT + d * 4096 + t32_off(e4 + 1, dk)) = (bf16)f2bf(sv.y);
          *(LAS bf16*)(SCT + d * 4096 + t32_off(e4 + 2, dk)) = (bf16)f2bf(sv.z); *(LAS bf16*)(SCT + d * 4096 + t32_off(e4 + 3, dk)) = (bf16)f2bf(sv.w); } }
    __syncthreads();
    { int lane = C.lane; asm volatile("" : "+v"(lane)); const int q = lane >> 4, c = lane & 15, w = C.wave, d = w >> 2, mt = w & 3;
      const bf16x8 a = frag32(QT + d * 4096, mt * 16, lane);
#pragma unroll
      for (int nt = 0; nt < 4; ++nt) { f32x4 acc = {0.f, 0.f, 0.f, 0.f}; acc = MFMA16(a, frag32(KT + d * 4096, nt * 16, lane), acc);
#pragma unroll
          for (int r = 0; r < 4; ++r) { const int t = mt * 16 + 4 * q + r, s_ = nt * 16 + c; const bool keep = d ? (s_ >= t) : (s_ <= t);
              *(LAS bf16*)(AM + d * 8192 + t64_off(t, s_)) = (bf16)f2bf(keep ? acc[r] : 0.f); } } }
    __syncthreads();
    { int lane = C.lane; asm volatile("" : "+v"(lane)); const int q = lane >> 4, c = lane & 15, w = C.wave, d = w >> 2, ntk = w & 3;
      float* og = C.wsf(WS_OGLA) + ((size_t)d * M + ci.row0 + ntk * 16 + c) * 256 + h * 64 + 4 * q;
      const bf16x8 bq = frag32(QT + d * 4096, ntk * 16, lane), b0 = frag64(AM + d * 8192, ntk * 16, 0, lane), b1 = frag64(AM + d * 8192, ntk * 16, 32, lane);
#pragma unroll
      for (int me = 0; me < 4; ++me) { f32x4 acc = {0.f, 0.f, 0.f, 0.f};
          acc = MFMA16(frag64(C.lds + GL_VT, me * 16, 0, lane), b0, acc); acc = MFMA16(frag64(C.lds + GL_VT, me * 16, 32, lane), b1, acc);
          acc = MFMA16(frag32(SCT + d * 4096, me * 16, lane), bq, acc);
          *(f32x4*)(og + me * 16) = acc; } }
    __syncthreads();
}
__device__ __forceinline__ int t256_off(int row, int col) { return row * 512 + (((col >> 3) ^ (row & 15)) << 4) + (col & 7) * 2; }
__device__ __forceinline__ void s5_out_blk(Ctx& C, int l, int bi) {
    const int gd = bi & 31, g = gd >> 1, d = gd & 1, cg = bi >> 5, p = C.lane, q = p >> 4, c = p & 15;
    LAS unsigned char* BB = C.lds + S5_BB; LAS unsigned char* CB = C.lds + S5_CB;
    LAS float* BUT = (LAS float*)(C.lds + S5_BUT + C.wave * 8448); LAS unsigned char* HT = C.lds + S5_HT + C.wave * 4096;
    const bf16* PROJ = C.wsb(WS_PROJ); const float* S5HS = C.wsf(WS_S5HS); float* YS5 = C.wsf(WS_YS5);
    const int gi = (l * 2 + d) * 16 + g;
    { const float* cre = C.inp(I_CRE) + (size_t)gi * 1024; const float* cim = C.inp(I_CIM) + (size_t)gi * 1024;
#pragma unroll
      for (int k = 0; k < 4; ++k) { const int idx = C.tid + k * NTHR, ch = idx >> 7, kk = idx & 127;
          *(LAS bf16*)(CB + t128_off(ch, kk)) = (bf16)f2bf(kk < 64 ? cre[ch * 64 + kk] : -cim[ch * 64 + kk - 64]); } }
    S5Par P; s5_setup(C, l, d, g, p, P);
    if (C.wave == 0) s5_write_bb(P, BB, p);
    __syncthreads();
    const float lbr = (float)P.lbr, lbi = (float)P.lbi;
    bf16x8 ufr[2][4]; float hs[2][2];
#pragma unroll
    for (int j = 0; j < 2; ++j) { const size_t item = (size_t)((cg * 16 + C.wave * 2 + j) * 16 + g) * 2 + d; hs[j][0] = S5HS[item * 128 + p]; hs[j][1] = S5HS[item * 128 + 64 + p];
#pragma unroll
        for (int qq = 0; qq < 4; ++qq) ufr[j][qq] = s5_load_uf(PROJ, cg * 16 + C.wave * 2 + j, g, d ? 48 - 16 * qq : 16 * qq, p); }
#pragma unroll
    for (int j = 0; j < 2; ++j) { const int gc = cg * 16 + C.wave * 2 + j;
        float hr = hs[j][0], hi = hs[j][1];
#pragma unroll
        for (int qq = 0; qq < 4; ++qq) { const int tb = d ? 48 - 16 * qq : 16 * qq;
            s5_bu_quarter(ufr[j][qq], BB, BUT, p);
#pragma unroll
            for (int ii = 0; ii < 16; ++ii) { const int tl = d ? 15 - ii : ii; const float br = BUT[tl * 132 + p], bi2 = BUT[tl * 132 + 64 + p];
                const float nr = lbr * hr - lbi * hi + br, ni = lbr * hi + lbi * hr + bi2; hr = nr; hi = ni;
                *(LAS bf16*)(HT + t128_off(tl, p)) = (bf16)f2bf(hr); *(LAS bf16*)(HT + t128_off(tl, 64 + p)) = (bf16)f2bf(hi); }
            asm volatile("s_waitcnt lgkmcnt(0)" ::: "memory");
            f32x4 acc = {0.f, 0.f, 0.f, 0.f};
#pragma unroll
            for (int ks = 0; ks < 4; ++ks) acc = MFMA16(frag128(HT, 0, ks * 32, p), frag128(CB, 0, ks * 32, p), acc);
#pragma unroll
            for (int r = 0; r < 4; ++r) YS5[((size_t)d * M + gc * 64 + tb + 4 * q + r) * 256 + g * 16 + c] = acc[r];
            asm volatile("s_waitcnt lgkmcnt(0)" ::: "memory"); } }
    __syncthreads();
}

__device__ __forceinline__ void sub_census(Ctx& C, unsigned* ctl) { if (C.tid == 0) (void)xb_add(ctl + 16 + xb_xcc_id(), 1u); }
__device__ __forceinline__ void sub_barrier(Ctx& C, unsigned* ctl, unsigned target) {
    asm volatile("s_waitcnt vmcnt(0)" ::: "memory");
    __syncthreads();
    if (C.tid == 0) {
        const unsigned x = xb_xcc_id();
        unsigned sum, mine, nx, sp = 0u;
        for (;;) {
            sum = 0u; mine = 0u; nx = 0u;
#pragma unroll
            for (unsigned j = 0; j < 16; ++j) { const unsigned c = xb_ld(ctl + 16 + j); sum += c; nx += (c > 0u) ? 1u : 0u; mine = (j == x) ? c : mine; }
            if (sum == target) break;
            __builtin_amdgcn_s_sleep(1); if (++sp > (1u << 20)) break;
        }
        const unsigned old = xb_add(ctl + 32 + x, 1u);
        if (old + 1u == mine) {
            __builtin_amdgcn_fence(__ATOMIC_RELEASE, "agent"); asm volatile("s_waitcnt vmcnt(0)" ::: "memory");
            (void)xb_add(ctl, 1u);
        }
        unsigned spins = 0;
        while (xb_ld(ctl) < nx) { __builtin_amdgcn_s_sleep(2); if (++spins > (1u << 22)) break; }
        __builtin_amdgcn_fence(__ATOMIC_ACQUIRE, "agent"); asm volatile("s_waitcnt vmcnt(0)" ::: "memory");
    }
    __syncthreads();
}
__device__ __forceinline__ int wq_next(Ctx& C, unsigned* q) {
    volatile LAS int* slot = (volatile LAS int*)(C.lds + LDS_CTL_OFF + 64);
    __syncthreads();
    if (C.tid == 0) *slot = (int)__hip_atomic_fetch_add(q, 1u, __ATOMIC_RELAXED, __HIP_MEMORY_SCOPE_AGENT);
    __syncthreads();
    return *slot;
}
__device__ __forceinline__ void ph_scan(Ctx& C, int l, int mode) {
    if (C.nb < 64) return;
    const int NS = C.nb - 16;
    if (C.vb < 16) { gdn_scan_unit(C, l, 16 + (C.vb >> 3), (C.vb >> 1) & 3, C.vb & 1, false); return; }
    unsigned* ctl = (unsigned*)(C.ws + WS_SUBBAR) + l * 256;
    sub_census(C, ctl);
#define WQ_CTX() Ctx Ci = C; { int t_ = C.tid; asm volatile("" : "+v"(t_)); Ci.tid = t_; Ci.lane = t_ & 63; }
#pragma unroll 1
    for (int it = wq_next(C, ctl + 64); it < 472; it = wq_next(C, ctl + 64)) { WQ_CTX();
        if (it < 256) gdn_prep_item(Ci, l, it >> 2, it & 3);
        else if (it < 400) { const int u = it - 256; gla_scan_unit(Ci, l, u >> 3, (u >> 1) & 3, u & 1); }
        else s5_scan_unit(Ci, l, (it - 400) * NWAVES + Ci.wave); }
    sub_barrier(C, ctl, (unsigned)NS);
#pragma unroll 1
    for (int it = wq_next(C, ctl + 128); it < 896; it = wq_next(C, ctl + 128)) { WQ_CTX();
        if (it < 128) { const int u = 16 + it; gdn_scan_unit(Ci, l, (u - 16) >> 3, (u >> 1) & 3, u & 1, false); }
        else if (it < 384) s5_out_blk(Ci, l, it - 128);
        else { const int g = it - 384; gla_out_item(Ci, l, g >> 2, g & 3); } }
#undef WQ_CTX
}

__device__ __forceinline__ void ph_post(Ctx& C, int l) {
    LAS unsigned char* Gb = C.lds;
    const int tid = C.tid, lane = C.lane, wave = C.wave;
    const bf16* PROJ = C.wsb(WS_PROJ); const float* YS5 = C.wsf(WS_YS5); const bf16* WGT = C.wsb(WS_WGLU); bf16* HNp = C.wsb(WS_HN); const bf16* OGD = C.wsb(WS_OGDN); const float* OGLAp = C.wsf(WS_OGLA);
    const float* glanw = C.inp(I_GLANW); const float* gdnnw = C.inp(I_GDNNW); const float* s5d = C.inp(I_S5D); const float* wglu = C.inp(I_WGLU); const float* bglu = C.inp(I_BGLU);
    for (int tile = C.vb; tile < 256; tile += C.nb) {
        const int r0 = tile * 32;
#pragma unroll
        for (int kb = 0; kb < 16; kb += 8) {
            float o[8], gt[8], ss[8];
#pragma unroll
            for (int k = 0; k < 8; ++k) { const int pr = wave + (kb + k) * NWAVES, row = r0 + (pr >> 2), h = pr & 3;
                o[k] = OGLAp[(size_t)row * 256 + h * 64 + lane] + OGLAp[((size_t)M + row) * 256 + h * 64 + lane]; gt[k] = bf2f(PROJ[(size_t)row * NINP + C_GOG + h * 64 + lane]); ss[k] = o[k] * o[k]; }
#pragma unroll
            for (int off = 1; off < 64; off <<= 1) { float v[8];
#pragma unroll
                for (int k = 0; k < 8; ++k) v[k] = __shfl_xor(ss[k], off);
#pragma unroll
                for (int k = 0; k < 8; ++k) ss[k] += v[k]; }
            const float nwv = glanw[l * 64 + lane];
#pragma unroll
            for (int k = 0; k < 8; ++k) { const int pr = wave + (kb + k) * NWAVES, row = r0 + (pr >> 2), h = pr & 3;
                HNp[(size_t)row * D + h * 64 + lane] = (bf16)f2bf(o[k] * __builtin_amdgcn_rsqf(ss[k] * (1.f / 64.f) + 1e-6f) * nwv * siluf(gt[k])); } }
#pragma unroll
        for (int kb = 0; kb < 16; kb += 8) {
            float o0[8], o1[8], ss[8]; unsigned gg[8];
#pragma unroll
            for (int k = 0; k < 8; ++k) { const int pr = wave + (kb + k) * NWAVES, row = r0 + (pr >> 2), h = pr & 3;
                const unsigned a0 = *(const unsigned*)(OGD + (size_t)row * 512 + h * 128 + 2 * lane), a1 = *(const unsigned*)(OGD + ((size_t)M + row) * 512 + h * 128 + 2 * lane);
                gg[k] = *(const unsigned*)(PROJ + (size_t)row * NINP + C_DOG + h * 128 + 2 * lane);
                o0[k] = bflo(a0) + bflo(a1); o1[k] = bfhi(a0) + bfhi(a1); ss[k] = o0[k] * o0[k] + o1[k] * o1[k]; }
#pragma unroll
            for (int off = 1; off < 64; off <<= 1) { float v[8];
#pragma unroll
                for (int k = 0; k < 8; ++k) v[k] = __shfl_xor(ss[k], off);
#pragma unroll
                for (int k = 0; k < 8; ++k) ss[k] += v[k]; }
            const float nw0 = gdnnw[l * 128 + 2 * lane], nw1 = gdnnw[l * 128 + 2 * lane + 1];
#pragma unroll
            for (int k = 0; k < 8; ++k) { const int pr = wave + (kb + k) * NWAVES, row = r0 + (pr >> 2), h = pr & 3; const float rs = __builtin_amdgcn_rsqf(ss[k] * (1.f / 128.f) + 1e-6f);
                *(unsigned*)(HNp + (size_t)row * D + 256 + h * 128 + 2 * lane) = pk2(o0[k] * rs * nw0 * siluf(bflo(gg[k])), o1[k] * rs * nw1 * siluf(bfhi(gg[k]))); } }
        for (int idx = tid; idx < 32 * 256; idx += NTHR) { const int tk = idx >> 8, row = r0 + tk, cix = idx & 255;
            const float y = bf2f(PROJ[(size_t)row * NINP + C_SU + cix]) * s5d[l * 256 + cix] + YS5[(size_t)row * 256 + cix] + YS5[((size_t)M + row) * 256 + cix];
            const float in = 0.7978845608028654f * (y + 0.044715f * y * y * y);
            *(LAS bf16*)(Gb + t256_off(tk, cix)) = (bf16)f2bf(0.5f * y * (2.0f - 2.0f * __builtin_amdgcn_rcpf(1.0f + __expf(2.0f * in)))); }
        __syncthreads();
        { const int q = lane >> 4, c = lane & 15;
          f32x4 acc[2][2];
#pragma unroll
          for (int a = 0; a < 2; ++a)
#pragma unroll
              for (int m = 0; m < 2; ++m) acc[a][m] = (f32x4){0.f, 0.f, 0.f, 0.f};
          const bf16* wt = WGT + (size_t)(wave * 32 + c) * 256 + 8 * q;
#pragma unroll
          for (int ks = 0; ks < 8; ++ks) { const bf16x8 a0 = *(const bf16x8*)(wt + ks * 32), a1 = *(const bf16x8*)(wt + 16 * 256 + ks * 32);
              const bf16x8 b0 = *(const LAS bf16x8*)(Gb + c * 512 + (((4 * ks + q) ^ c) << 4)), b1 = *(const LAS bf16x8*)(Gb + (16 + c) * 512 + (((4 * ks + q) ^ c) << 4));
              acc[0][0] = MFMA16(a0, b0, acc[0][0]); acc[0][1] = MFMA16(a0, b1, acc[0][1]); acc[1][0] = MFMA16(a1, b0, acc[1][0]); acc[1][1] = MFMA16(a1, b1, acc[1][1]); }
          f32x4 bgv[2];
#pragma unroll
          for (int a = 0; a < 2; ++a) bgv[a] = *(const f32x4*)(bglu + l * 256 + wave * 32 + a * 16 + 4 * q);
#pragma unroll
          for (int a = 0; a < 2; ++a)
#pragma unroll
              for (int m = 0; m < 2; ++m) { const int n0 = wave * 32 + a * 16 + 4 * q, tk = m * 16 + c;
                  const v2u gv = *(const LAS v2u*)(Gb + t256_off(tk, n0)); const f32x4 bg = bgv[a];
                  v2u o; o.x = pk2(bflo(gv.x) * sigmf(acc[a][m][0] + bg.x), bfhi(gv.x) * sigmf(acc[a][m][1] + bg.y)); o.y = pk2(bflo(gv.y) * sigmf(acc[a][m][2] + bg.z), bfhi(gv.y) * sigmf(acc[a][m][3] + bg.w));
                  *(v2u*)(HNp + (size_t)(r0 + tk) * D + 768 + n0) = o; } }
        __syncthreads();
    }
}
constexpr int REP_KIND = -1, REP_N = 1;
#ifndef PHASE_MASK
#define PHASE_MASK 0xffffffffu
#endif
constexpr int PH_PER_LAYER = 11, N_PHASES = 1 + 2 * PH_PER_LAYER + 1;
#define MKCTX() Ctx C; { int tid_ = threadIdx.x; asm volatile("" : "+v"(tid_)); int vbr_ = blockIdx.x; asm volatile("" : "+s"(vbr_)); \
    C.lds = (LAS unsigned char*)lds_raw; C.tid = tid_; C.lane = tid_ & 63; C.wave = __builtin_amdgcn_readfirstlane(tid_ >> 6); \
    C.nb = gridDim.x; C.vb_raw = vbr_; C.vb = (C.nb % 8 == 0) ? (vbr_ % 8) * (C.nb / 8) + vbr_ / 8 : vbr_; \
    C.out = (float*)(GAS float*)C.ptab(34); C.ws = (unsigned char*)(GAS unsigned char*)C.ptab(35); }
#define IN(k) (lo <= (k) && (k) < hi)
#define SEAM(k) do { if ((k) + 1 < hi) xcd_barrier(bar); } while (0)
__device__ __forceinline__ float* ss_ptr(Ctx& C, int l, int inst) { return (float*)(C.ws + WS_SS) + (size_t)(l * 3 + inst) * M; }
template <int KIND>
__device__ __forceinline__ void gemm_res(Ctx& C, int l) {
    constexpr int j = KIND == 13; constexpr int KF = KIND == 10 ? D : FF; const bool first = (l == 0 && KIND == 3);
    pg8::Gemm g{KIND == 10 ? C.wsb(WS_HN) : C.wsb(WS_H), KIND == 10 ? C.wsb(WS_WOUT) : C.wsb(WS_WD) + (size_t)j * D * FF, M, D, KF, KF}; pg8::StaticOrder S; S.init(M, D, C.nb, C.vb_raw, 1, 128);
    constexpr int gi = KIND == 3 ? 2 : (KIND == 10 ? 5 : 8);
    const int nl = KIND == 13 ? l + 1 : l, ninst = KIND == 3 ? 1 : (KIND == 10 ? 2 : 0); const bool has_next = nl < 2;
    pg8::EpiRes<true> E{C.inp(I_XP), C.inp(I_XS), (bf16*)C.outp(), has_next ? (bf16*)C.outp() : C.wsb(WS_HN)  , KIND == 10 ? C.wsb(WS_HN2) : C.wsb(WS_HN), has_next ? ss_ptr(C, nl, ninst) : nullptr,
                  has_next ? C.wsf(WS_CW) + (size_t)(nl * 3 + ninst) * 3 * D : nullptr, C.wsf(WS_MOD) + (size_t)l * 3 * 9216 + gi * D, KIND == 10 ? 1.0f : 0.5f, first};
    pg8::gemm_phase<pg8::EpiRes<true>, pg8::StaticOrder, true, true, true>(C.lds, g, S, E, C.tid);
}
template <class Sched>
__device__ __forceinline__ const LAS float* fill_epi_lds(Ctx& C, const Sched& S, const float* SS, const float* bias, int ncols) {
    LAS float* EP = (LAS float*)(C.lds + 131072);
    for (int i = 0; i < 8; ++i) { pg8::Unit u; if (!S.next(i, u)) break;
        const int cid = u.pm < 16 ? 0 : 1 + ((u.pm - 16) >> 3), t = C.tid;
        EP[i * 512 + t] = t < 256 ? 1.0f / sqrtf(SS[u.pm * 256 + t] * (1.f / D) + 1e-6f) : bias[(size_t)cid * ncols + u.pn * 256 + (t - 256)]; }
    __syncthreads();
    return EP;
}
__device__ __forceinline__ void gemm_gu(Ctx& C, int l, int j) {
    pg8::Gemm g{j ? C.wsb(WS_HN2) : C.wsb(WS_HN), C.wsb(WS_WGU) + (size_t)j * NGU * D, M, NGU, D, D}; pg8::StaticOrder S; S.init(M, NGU, C.nb, C.vb_raw);
    pg8::EpiGU E{C.wsb(WS_H), fill_epi_lds(C, S, ss_ptr(C, l, j ? 2 : 0), bgu_ptr(C, l, j), NGU)};
    pg8::gemm_phase<pg8::EpiGU, pg8::StaticOrder, true, true>(C.lds, g, S, E, C.tid);
}
__device__ __forceinline__ void gemm_inproj(Ctx& C, int l) {
    pg8::Gemm g{C.wsb(WS_HN), C.wsb(WS_WIN), M, NINP, D, D}; pg8::StaticOrder S; S.init(M, NINP, C.nb, C.vb_raw);
    pg8::EpiProj E{C.wsb(WS_PROJ), NINP, fill_epi_lds(C, S, ss_ptr(C, l, 1), bin_ptr(C, l), NINP)};
    pg8::gemm_phase<pg8::EpiProj, pg8::StaticOrder, true, true>(C.lds, g, S, E, C.tid);
}
__global__ void __launch_bounds__(NTHR, 2) fwd_kernel(Args a) {
    extern __shared__ __attribute__((aligned(16))) unsigned char lds_raw[];
    volatile LAS unsigned* MISC = (volatile LAS unsigned*)((LAS unsigned char*)lds_raw + LDS_CTL_OFF);
    if (threadIdx.x < 64) MISC[threadIdx.x] = 0u;
    if (threadIdx.x < 36) { const unsigned long long v = threadIdx.x < 34 ? (unsigned long long)a.in[threadIdx.x] : (threadIdx.x == 34 ? (unsigned long long)a.out : (unsigned long long)a.ws);
        MISC[64 + 2 * threadIdx.x] = (unsigned)v; MISC[64 + 2 * threadIdx.x + 1] = (unsigned)(v >> 32); }
    __syncthreads();
    XcdBarrier bar = xcd_barrier_post((unsigned*)(a.ws + WS_CTL) + CW_BAR, MISC + 8);
    const int lo = a.ph_lo, hi = a.ph_hi;
#define PHASE(k, kind, ...) if (((PHASE_MASK >> ((kind) & 31)) & 1u) && IN(k)) { const int nrep_ = ((kind) == REP_KIND) ? REP_N : 1; _Pragma("unroll 1") for (int rep = 0; rep < nrep_; ++rep) { MKCTX(); __VA_ARGS__; } SEAM(k); }
    PHASE(0, 20, ph_mod(C); __syncthreads(); if (C.vb >= 32) wconv_set<false, W_A, W_B, W_GLU, W_END>(C, 0, C.vb - 32, C.nb - 32))
#define LAYER(l) { constexpr int b = 1 + (l) * PH_PER_LAYER; \
        if ((l) == 0) { PHASE(b + 1, 1, ph_bias(C, l, 0); ph_xb0(C); wconv_stage_shift(C, l); wconv_set<true, W_B, W_DA>(C, l, C.vb, C.nb)) } \
        PHASE(b + 2, 2, gemm_gu(C, l, 0); if ((l) == 0) tail_fill<true, W_DA, W_DB, W_IN, W_OUT>(C, l, 704); else tail_fill<true, W_IN, W_OUT>(C, l, 704)) \
        PHASE(b + 3, 3, gemm_res<3>(C, l)) \
        PHASE(b + 4, 5, gemm_inproj(C, l); if ((l) == 0) { tail_fill<false, W_OUT, W_GLU>(C, l, 416); tail_fill<true, W_DA, W_DB, W_A, W_A + I_G>(C, (l) + 1, 416); } else tail_fill<true, W_B, W_DA, W_OUT, W_END>(C, l, 416)) \
        PHASE(b + 5, 6, ph_prep(C, l)) \
        PHASE(b + 6, 7, ph_scan(C, l, 0)) \
        PHASE(b + 7, 9, ph_post(C, l)) \
        PHASE(b + 8, 10, gemm_res<10>(C, l)) \
        PHASE(b + 9, 2, gemm_gu(C, l, 1); if ((l) == 0) { tail_fill<false, W_DB, W_IN>(C, l, 704); tail_fill<true, W_A + I_G, W_B>(C, (l) + 1, 704); } else tail_fill<false, W_DB, W_IN>(C, l, 704)) \
        PHASE(b + 10, 3, gemm_res<13>(C, l)) }
    LAYER(0)
    LAYER(1)
    if (IN(N_PHASES - 1)) { MKCTX(); FinalRows F; ph_final_load(C, F); ph_final_store(C, F); if (REP_KIND == 100) for (int rep = 0; rep < REP_N; ++rep) xcd_barrier(bar); }
}

extern "C" void kernel_launch(void* const* d_in, const int* in_sizes, int n_in, void* d_out, int out_size, void* d_ws, size_t ws_size, hipStream_t stream) {
    static int grid = 0;
    if (grid == 0) {
        if (n_in != 34 || (size_t)out_size != O_END || ws_size < WS_END) { fprintf(stderr, "kernel_launch: unexpected shapes: n_in %d out %d ws %zu\n", n_in, out_size, ws_size); grid = -1; return; }
        int dev = 0, cus = 0, per_cu = 0;
        if (hipGetDevice(&dev) != hipSuccess || hipDeviceGetAttribute(&cus, hipDeviceAttributeMultiprocessorCount, dev) != hipSuccess) { grid = -1; return; }
        if (hipFuncSetAttribute((const void*)fwd_kernel, hipFuncAttributeMaxDynamicSharedMemorySize, LDS_BYTES) != hipSuccess) { fprintf(stderr, "kernel_launch: hipFuncSetAttribute failed\n"); grid = -1; return; }
        if (hipOccupancyMaxActiveBlocksPerMultiprocessor(&per_cu, (const void*)fwd_kernel, NTHR, LDS_BYTES) != hipSuccess || per_cu < 1) fprintf(stderr, "kernel_launch: occupancy query says %d\n", per_cu);
        (void)hipGetLastError();
        grid = cus;
    }
    if (grid < 0) return;
    (void)hipMemsetAsync((char*)d_ws + WS_CTL, 0, CTL_ZERO_BYTES, stream);
    Args a{};
    for (int i = 0; i < 34; ++i) a.in[i] = (const float*)d_in[i];
    a.out = (float*)d_out; a.ws = (unsigned char*)d_ws;
#ifndef ONE_LAUNCH
#define ONE_LAUNCH 1
#endif
#ifndef PROBE_PREFIX
#define PROBE_PREFIX 0
#endif
    if (PROBE_PREFIX > 0) { a.ph_lo = 0; a.ph_hi = PROBE_PREFIX; hipLaunchKernelGGL(fwd_kernel, dim3(grid), dim3(NTHR), LDS_BYTES, stream, a); (void)hipMemsetAsync((char*)d_ws + WS_CTL, 0, CTL_ZERO_BYTES, stream); }
    if (ONE_LAUNCH) { a.ph_lo = 0; a.ph_hi = N_PHASES; hipLaunchKernelGGL(fwd_kernel, dim3(grid), dim3(NTHR), LDS_BYTES, stream, a); }
    else for (int ph = 0; ph < N_PHASES; ++ph) { a.ph_lo = ph; a.ph_hi = ph + 1; hipLaunchKernelGGL(fwd_kernel, dim3(grid), dim3(NTHR), LDS_BYTES, stream, a); }
}
```
